# Optimizing an MI355X kernel written in HIP

```python
import math
import jax, jax.numpy as jnp
from jax import lax
import numpy as np

D_MODEL = 2048
BATCH = 4
SEQ = 2048
DEPTH = 2
DEC_BATCH = 128
DEC_SEQ = 8
PAST_LEN = 16384
PAGE_SIZE = 128

N_MIXERS = 2
N_RET = (DEPTH + 1) // 2
N_GDN = DEPTH // 2
RET_HEADS = D_MODEL // 256
RET_DK = D_MODEL // RET_HEADS
RET_DV = 2 * D_MODEL // RET_HEADS
RET_QK = RET_HEADS * RET_DK
RET_V = RET_HEADS * RET_DV
RET_IN = 2 * RET_QK + 2 * RET_V
ROPE_BASE = 10000.0
GDN_DK = 128
GDN_DV = 128
GDN_K_HEADS = D_MODEL // 128
GDN_V_HEADS = 2 * GDN_K_HEADS
GDN_QK = GDN_K_HEADS * GDN_DK
GDN_V = GDN_V_HEADS * GDN_DV
GDN_CONV_CH = 2 * GDN_QK + GDN_V
GDN_IN = GDN_CONV_CH + GDN_V + 2 * GDN_V_HEADS
CONV_W = 4
D_FF = 5632
FFN_RES = 0.5
N_SUB = 3
CHUNK = 64
EPS = 1e-6

kernel_name = 'retnet_gated_deltanet_macaron_adaln_step'


def rmsnorm(x, w=None):
    xf = x.astype(jnp.float32)
    y = xf * lax.rsqrt(jnp.mean(xf * xf, -1, keepdims=True) + EPS)
    if w is not None:
        y = y * w.astype(jnp.float32)
    return y.astype(x.dtype)


def l2norm(x):
    return x * lax.rsqrt(jnp.sum(x * x, -1, keepdims=True) + EPS)


def swiglu(h, w_gu, w_down):
    gate, up = jnp.split(h @ w_gu, 2, axis=-1)
    return (jax.nn.silu(gate) * up) @ w_down


def adaln_in(x, mod, j, w):
    return rmsnorm(x, w) * (1 + mod[:, j, 1]) + mod[:, j, 0]


def adaln_out(y, mod, j, w):
    return mod[:, j, 2] * rmsnorm(y, w)


def rotary(x, pos):
    half = x.shape[-1] // 2
    inv = 1.0 / (ROPE_BASE ** jnp.linspace(0.0, 1.0, half, dtype=jnp.float32))
    ang = pos.astype(jnp.float32)[:, None] * inv[None, :]
    cos = jnp.cos(ang)[None, :, None, :]
    sin = jnp.sin(ang)[None, :, None, :]
    x1, x2 = x[..., :half], x[..., half:]
    return jnp.concatenate([x1 * cos - x2 * sin, x1 * sin + x2 * cos], axis=-1)


def to_chunks(t, n, c):
    b, _, h = t.shape[:3]
    t = t.reshape((b, n, c, h) + t.shape[3:])
    perm = (1, 0, 3, 2) + tuple(range(4, t.ndim))
    return t.transpose(perm)


def from_chunks(t):
    n, b, h, c, d = t.shape
    return t.transpose(1, 0, 3, 2, 4).reshape(b, n * c, h, d)


def retention_chunked(q, k, v, s0):
    _, L, H, _ = q.shape
    C = math.gcd(CHUNK, L)
    N = L // C
    log_g = jnp.log1p(-jnp.exp2(-5.0 - jnp.arange(H, dtype=jnp.float32)))
    idx = jnp.arange(C, dtype=jnp.float32)
    diff = idx[:, None] - idx[None, :]
    causal = diff >= 0
    dmask = jnp.where(causal[None], jnp.exp(log_g[:, None, None] * jnp.where(causal, diff, 0.0)[None]), 0.0)
    q_decay = jnp.exp(log_g[:, None] * (idx[None, :] + 1.0))[None, :, :, None]
    k_decay = jnp.exp(log_g[:, None] * (C - 1.0 - idx)[None, :])[None, :, :, None]
    chunk_decay = jnp.exp(log_g * C)[None, :, None, None]

    def step(s, inp):
        qi, ki, vi = inp
        scores = jnp.einsum('bhid,bhjd->bhij', qi, ki) * dmask
        o = jnp.einsum('bhij,bhjv->bhiv', scores, vi) + jnp.einsum('bhid,bhdv->bhiv', qi, s) * q_decay
        s = s * chunk_decay + jnp.einsum('bhjd,bhjv->bhdv', ki * k_decay, vi)
        return s, o

    s_fin, out = lax.scan(step, s0, (to_chunks(q, N, C), to_chunks(k, N, C), to_chunks(v, N, C)))
    return from_chunks(out), s_fin


def retention_mixer(h, w_in, w_out, s0, pos0):
    B, L, _ = h.shape
    f32 = jnp.float32
    q, k, v, g = jnp.split(h @ w_in, [RET_QK, 2 * RET_QK, 2 * RET_QK + RET_V], axis=-1)
    pos = pos0 + jnp.arange(L)
    q = rotary(q.reshape(B, L, RET_HEADS, RET_DK).astype(f32), pos) * (RET_DK ** -0.5)
    k = rotary(k.reshape(B, L, RET_HEADS, RET_DK).astype(f32), pos)
    v = v.reshape(B, L, RET_HEADS, RET_DV).astype(f32)
    o, s = retention_chunked(q, k, v, s0.astype(f32))
    o = rmsnorm(o).reshape(B, L, RET_V)
    o = jax.nn.silu(g.astype(f32)) * o
    return o.astype(h.dtype) @ w_out, s.astype(s0.dtype)


def causal_conv(u, buf, w):
    L = u.shape[1]
    full = jnp.concatenate([buf.astype(u.dtype), u], axis=1)
    out = full[:, 0:L] * w[0]
    for j in range(1, CONV_W):
        out = out + full[:, j:j + L] * w[j]
    return jax.nn.silu(out), full[:, -(CONV_W - 1):]


def gated_delta_chunked(q, k, v, g, beta, s0):
    _, L, H, dk = q.shape
    dv = v.shape[-1]
    C = math.gcd(CHUNK, L)
    N = L // C
    qc, kc, vc = to_chunks(q, N, C), to_chunks(k, N, C), to_chunks(v, N, C)
    bc = to_chunks(beta, N, C)[..., None]
    gc = jnp.cumsum(to_chunks(g, N, C), axis=-1)
    tri = jnp.tril(jnp.ones((C, C), dtype=bool))
    strict = jnp.tril(jnp.ones((C, C), dtype=bool), -1)
    decay = jnp.exp(jnp.where(tri, gc[..., :, None] - gc[..., None, :], -jnp.inf))
    kb = kc * bc
    lmat = jnp.where(strict, jnp.einsum('nbhid,nbhjd->nbhij', kb, kc) * decay, 0.0)
    a_mat = lmat + jnp.eye(C, dtype=lmat.dtype)
    rhs = jnp.concatenate([vc * bc, kb * jnp.exp(gc)[..., None]], axis=-1)
    sol = lax.linalg.triangular_solve(a_mat, rhs, left_side=True, lower=True, unit_diagonal=True)
    uc, wc = sol[..., :dv], sol[..., dv:]
    attn = jnp.where(tri, jnp.einsum('nbhid,nbhjd->nbhij', qc, kc) * decay, 0.0)

    def step(s, inp):
        qi, ki, ui, wi, gi, ai = inp
        v_new = ui - jnp.einsum('bhcd,bhdv->bhcv', wi, s)
        o = jnp.einsum('bhcd,bhdv->bhcv', qi * jnp.exp(gi)[..., None], s) + jnp.einsum('bhij,bhjv->bhiv', ai, v_new)
        g_last = gi[..., -1:]
        s = s * jnp.exp(g_last)[..., None] + jnp.einsum('bhcd,bhcv->bhdv', ki * jnp.exp(g_last - gi)[..., None], v_new)
        return s, o

    s_fin, out = lax.scan(step, s0, (qc, kc, uc, wc, gc, attn))
    return from_chunks(out), s_fin


def gdn_mixer(h, w_in, conv_w, a_log, dt_bias, norm_w, w_out, s0, buf0):
    B, L, _ = h.shape
    f32 = jnp.float32
    qkv, z, a, b = jnp.split(h @ w_in, [GDN_CONV_CH, GDN_CONV_CH + GDN_V, GDN_CONV_CH + GDN_V + GDN_V_HEADS], axis=-1)
    qkv_c, buf = causal_conv(qkv, buf0, conv_w)
    q, k, v = jnp.split(qkv_c.astype(f32), [GDN_QK, 2 * GDN_QK], axis=-1)
    rep = GDN_V_HEADS // GDN_K_HEADS
    q = jnp.repeat(l2norm(q.reshape(B, L, GDN_K_HEADS, GDN_DK)), rep, axis=2) * (GDN_DK ** -0.5)
    k = jnp.repeat(l2norm(k.reshape(B, L, GDN_K_HEADS, GDN_DK)), rep, axis=2)
    v = v.reshape(B, L, GDN_V_HEADS, GDN_DV)
    g = -jnp.exp(a_log.astype(f32)) * jax.nn.softplus(a.astype(f32) + dt_bias.astype(f32))
    beta = jax.nn.sigmoid(b.astype(f32))
    o, s = gated_delta_chunked(q, k, v, g, beta, s0.astype(f32))
    o = rmsnorm(o, norm_w) * jax.nn.silu(z.reshape(B, L, GDN_V_HEADS, GDN_DV).astype(f32))
    return o.reshape(B, L, GDN_V).astype(h.dtype) @ w_out, s.astype(s0.dtype), buf.astype(buf0.dtype)


def trunk(x, c, pos0, ret_state, gdn_state, conv_state, w_ada, b_ada, norm_pre, norm_post,
          ffn_w_gu, ffn_w_down, ret_w_in, ret_w_out, gdn_w_in, gdn_conv_w, gdn_a_log,
          gdn_dt_bias, gdn_norm_w, gdn_w_out):
    B = x.shape[0]
    cs = jax.nn.silu(c)
    new_ret, new_gdn, new_conv = [], [], []
    for i in range(DEPTH):
        mod = (cs @ w_ada[i] + b_ada[i]).reshape(B, N_SUB, 3, 1, D_MODEL)
        h = adaln_in(x, mod, 0, norm_pre[i, 0])
        x = x + FFN_RES * adaln_out(swiglu(h, ffn_w_gu[i, 0], ffn_w_down[i, 0]), mod, 0, norm_post[i, 0])
        h = adaln_in(x, mod, 1, norm_pre[i, 1])
        r = i // N_MIXERS
        if i % N_MIXERS == 0:
            y, s = retention_mixer(h, ret_w_in[r], ret_w_out[r], ret_state[r], pos0)
            new_ret.append(s)
        else:
            y, s, buf = gdn_mixer(h, gdn_w_in[r], gdn_conv_w[r], gdn_a_log[r], gdn_dt_bias[r],
                                  gdn_norm_w[r], gdn_w_out[r], gdn_state[r], conv_state[r])
            new_gdn.append(s)
            new_conv.append(buf)
        x = x + adaln_out(y, mod, 1, norm_post[i, 1])
        h = adaln_in(x, mod, 2, norm_pre[i, 2])
        x = x + FFN_RES * adaln_out(swiglu(h, ffn_w_gu[i, 1], ffn_w_down[i, 1]), mod, 2, norm_post[i, 2])
    return x, jnp.stack(new_ret), jnp.stack(new_gdn), jnp.stack(new_conv)


def setup_inputs(seed: int = 0) -> dict:
    key = jax.random.key(seed)
    ks = jax.random.split(key, 24)
    f32 = jnp.float32
    nrm = lambda k, shape, s: jax.random.normal(k, shape, f32) * s
    dt = jnp.exp(jax.random.uniform(ks[20], (N_GDN, GDN_V_HEADS), f32, math.log(0.001), math.log(0.1)))
    return {
        'x_prompt': nrm(ks[0], (BATCH, SEQ, D_MODEL), 1.0),
        'x_sample': nrm(ks[1], (DEC_BATCH, DEC_SEQ, D_MODEL), 1.0),
        'c_prompt': nrm(ks[2], (BATCH, D_MODEL), 1.0),
        'c_sample': nrm(ks[3], (DEC_BATCH, D_MODEL), 1.0),
        'state_ret': nrm(ks[4], (N_RET, DEC_BATCH, RET_HEADS, RET_DK, RET_DV), 1.0),
        'state_gdn': nrm(ks[5], (N_GDN, DEC_BATCH, GDN_V_HEADS, GDN_DK, GDN_DV), 0.3),
        'state_conv': nrm(ks[6], (N_GDN, DEC_BATCH, CONV_W - 1, GDN_CONV_CH), 1.0),
        'w_ada': nrm(ks[7], (DEPTH, D_MODEL, N_SUB * 3 * D_MODEL), D_MODEL ** -0.5),
        'b_ada': nrm(ks[8], (DEPTH, N_SUB * 3 * D_MODEL), 0.02),
        'norm_pre': 1.0 + nrm(ks[9], (DEPTH, N_SUB, D_MODEL), 0.05),
        'norm_post': 1.0 + nrm(ks[10], (DEPTH, N_SUB, D_MODEL), 0.05),
        'ffn_w_gu': nrm(ks[11], (DEPTH, 2, D_MODEL, 2 * D_FF), D_MODEL ** -0.5),
        'ffn_w_down': nrm(ks[12], (DEPTH, 2, D_FF, D_MODEL), D_FF ** -0.5),
        'ret_w_in': nrm(ks[13], (N_RET, D_MODEL, RET_IN), D_MODEL ** -0.5),
        'ret_w_out': nrm(ks[14], (N_RET, RET_V, D_MODEL), RET_V ** -0.5),
        'gdn_w_in': nrm(ks[15], (N_GDN, D_MODEL, GDN_IN), D_MODEL ** -0.5),
        'gdn_conv_w': nrm(ks[16], (N_GDN, CONV_W, GDN_CONV_CH), CONV_W ** -0.5),
        'gdn_a_log': jnp.log(jax.random.uniform(ks[17], (N_GDN, GDN_V_HEADS), f32, 1.0, 16.0)),
        'gdn_dt_bias': dt + jnp.log(-jnp.expm1(-dt)),
        'gdn_norm_w': 1.0 + nrm(ks[18], (N_GDN, GDN_DV), 0.05),
        'gdn_w_out': nrm(ks[19], (N_GDN, GDN_V, D_MODEL), GDN_V ** -0.5),
    }


def reference(x_prompt, x_sample, c_prompt, c_sample, state_ret, state_gdn, state_conv,
              w_ada, b_ada, norm_pre, norm_post, ffn_w_gu, ffn_w_down, ret_w_in, ret_w_out,
              gdn_w_in, gdn_conv_w, gdn_a_log, gdn_dt_bias, gdn_norm_w, gdn_w_out):
    B = x_prompt.shape[0]
    dt = x_prompt.dtype
    ret0 = jnp.zeros((N_RET, B, RET_HEADS, RET_DK, RET_DV), dt)
    gdn0 = jnp.zeros((N_GDN, B, GDN_V_HEADS, GDN_DK, GDN_DV), dt)
    conv0 = jnp.zeros((N_GDN, B, CONV_W - 1, GDN_CONV_CH), dt)
    weights = (w_ada, b_ada, norm_pre, norm_post, ffn_w_gu, ffn_w_down, ret_w_in, ret_w_out,
               gdn_w_in, gdn_conv_w, gdn_a_log, gdn_dt_bias, gdn_norm_w, gdn_w_out)
    y_prompt, ret_p, gdn_p, conv_p = trunk(x_prompt, c_prompt, 0, ret0, gdn0, conv0, *weights)
    y_sample, ret_s, gdn_s, conv_s = trunk(x_sample, c_sample, PAST_LEN, state_ret, state_gdn, state_conv, *weights)
    return (y_prompt, y_sample, ret_p, ret_s, gdn_p, gdn_s, conv_p, conv_s)
```

```cpp
#include <hip/hip_runtime.h>
#include <cstdio>
#include <cstdint>
#define ONE_LAUNCH 0
namespace pg8 {
#define PG8_LAS __attribute__((address_space(3)))
typedef unsigned short bf16_t;
typedef short bf16x8 __attribute__((ext_vector_type(8)));
typedef float f32x4 __attribute__((ext_vector_type(4)));
typedef unsigned u32x4 __attribute__((ext_vector_type(4)));
constexpr int BM = 256, BK = 64, HALF = 128, HTB = HALF * BK * 2  , STAGE_BYTES = 8 * HTB, NXCD = 8, WGM = 8;

__host__ __device__ __forceinline__ int lds_byte(int r, int c) { const int st = (r >> 4) * 2 + (c >> 5), rr = r & 15, cc = c & 31, ob = rr * 64 + cc * 2; return st * 1024 + (ob ^ (((ob >> 9) & 1) << 5)); }
__host__ __device__ __forceinline__ void stage_rc(int b, int& R, int& C) { const int st = b / 1024, sb = b % 1024, swz = sb ^ (((sb >> 9) & 1) << 5); R = (st >> 1) * 16 + swz / 64; C = (st & 1) * 32 + (swz % 64) / 2; }
__host__ __device__ __forceinline__ int perm32(int rho) { const int n = rho >> 4, i = rho & 15; return 8 * (i >> 2) + 4 * n + (i & 3); }

struct Unit { int pm, pn; };
struct Gemm { const bf16_t* A; const bf16_t* Bt; int M, N, K; };

struct StaticOrder {
    int nM, nN, nwg, G, c;
    __host__ __device__ void init(int M, int N, int G_, int c_) { nM = M / BM; nN = N / BM; nwg = nM * nN; G = G_; c = c_; }
    __host__ __device__ bool next(int i, Unit& u) const {
        const long L = (long)i * G + c; if (L >= nwg) return false;
        int wgid = (int)L; { const int q = nwg / NXCD, r = nwg % NXCD, xcd = wgid % NXCD, off = wgid / NXCD; wgid = (xcd < r ? xcd * (q + 1) : r * (q + 1) + (xcd - r) * q) + off; }
        const int nig = WGM * nN, gid = wgid / nig, fm = gid * WGM, gsz = (nM - fm) < WGM ? (nM - fm) : WGM;
        u.pm = fm + ((wgid % nig) % gsz); u.pn = (wgid % nig) / gsz; return true;
    }
    __device__ __forceinline__ void a_ready(const Unit&) const {}
    __device__ __forceinline__ void done(const Unit&) const {}
};
typedef __bf16 bf16x2_t __attribute__((ext_vector_type(2)));
typedef float f32x2_t __attribute__((ext_vector_type(2)));
__device__ __forceinline__ unsigned cvt_pk_bf16(float lo, float hi) { const f32x2_t v = {lo, hi}; const bf16x2_t b = __builtin_convertvector(v, bf16x2_t); return __builtin_bit_cast(unsigned, b); }
typedef unsigned u32x2 __attribute__((ext_vector_type(2)));

struct EpiF32 {
    static constexpr bool PERM = false, AFTER_DRAIN = false;
    float* C; int ldc; const float* bias;
    __device__ __forceinline__ void operator()(const f32x4 (&acc)[2][2][4][2], const Unit& u, int wr, int wc, int fr, int fq) const {
        const int row0 = u.pm * BM + wr * 64 + fr, col0 = u.pn * BM + wc * 32 + 4 * fq;
        f32x4 bv[2][2];
#pragma unroll
        for (int bj = 0; bj < 2; ++bj)
#pragma unroll
            for (int n = 0; n < 2; ++n) bv[bj][n] = bias ? *(const f32x4*)(bias + col0 + bj * HALF + n * 16) : (f32x4){0.f, 0.f, 0.f, 0.f};
#pragma unroll
        for (int ai = 0; ai < 2; ++ai)
#pragma unroll
            for (int m = 0; m < 4; ++m) { float* rowp = C + (size_t)(row0 + ai * HALF + m * 16) * ldc + col0;
#pragma unroll
                for (int bj = 0; bj < 2; ++bj)
#pragma unroll
                    for (int n = 0; n < 2; ++n) *(f32x4*)(rowp + bj * HALF + n * 16) = acc[ai][bj][m][n] + bv[bj][n]; }
    }
};
struct EpiBf16G {
    static constexpr bool PERM = true, AFTER_DRAIN = false;
    bf16_t* O; int ldc; float* ab; int abtile;
    __device__ __forceinline__ void operator()(const f32x4 (&acc)[2][2][4][2], const Unit& u, int wr, int wc, int fr, int fq) const {
        const int row0 = u.pm * BM + wr * 64 + fr; const int col0 = u.pn * BM + wc * 32 + 8 * fq;
#pragma unroll
        for (int ai = 0; ai < 2; ++ai)
#pragma unroll
            for (int m = 0; m < 4; ++m) { bf16_t* rowp = O + (size_t)(row0 + ai * HALF + m * 16) * ldc + col0;
#pragma unroll
                for (int bj = 0; bj < 2; ++bj) { const f32x4 v0 = acc[ai][bj][m][0], v1 = acc[ai][bj][m][1];
                    u32x4 w; w.x = cvt_pk_bf16(v0[0], v0[1]); w.y = cvt_pk_bf16(v0[2], v0[3]); w.z = cvt_pk_bf16(v1[0], v1[1]); w.w = cvt_pk_bf16(v1[2], v1[3]);
                    *(u32x4*)(rowp + bj * HALF) = w; } }
        if (ab != nullptr && u.pn == abtile && wc < 2) {
#pragma unroll
            for (int ai = 0; ai < 2; ++ai)
#pragma unroll
                for (int m = 0; m < 4; ++m) { float* rp = ab + (size_t)(row0 + ai * HALF + m * 16) * 64 + wc * 32 + 8 * fq;
                    *(f32x4*)(rp) = acc[ai][0][m][0]; *(f32x4*)(rp + 4) = acc[ai][0][m][1]; }
        }
    }
};
struct EpiSwiGLU {
    static constexpr bool PERM = false, AFTER_DRAIN = false;
    bf16_t* O; int ldc;
    __device__ __forceinline__ void operator()(const f32x4 (&acc)[2][2][4][2], const Unit& u, int wr, int wc, int fr, int fq) const {
        const int row0 = u.pm * BM + wr * 64 + fr; const int col0 = u.pn * HALF + wc * 16 + 4 * fq;
#pragma unroll
        for (int ai = 0; ai < 2; ++ai)
#pragma unroll
            for (int m = 0; m < 4; ++m) { bf16_t* rowp = O + (size_t)(row0 + ai * HALF + m * 16) * ldc + col0;
#pragma unroll
                for (int bj = 0; bj < 2; ++bj) { const f32x4 g = acc[ai][bj][m][0], up = acc[ai][bj][m][1]; float r[4];
#pragma unroll
                    for (int j = 0; j < 4; ++j) r[j] = g[j] * __builtin_amdgcn_rcpf(1.0f + __expf(-g[j])) * up[j];
                    u32x2 w; w.x = cvt_pk_bf16(r[0], r[1]); w.y = cvt_pk_bf16(r[2], r[3]);
                    *(u32x2*)(rowp + bj * 64) = w; } }
    }
};
template <class Epi, class Sched, bool ALIGN_EPI = false, bool SP2 = false>
__device__ __forceinline__ void gemm_phase(PG8_LAS unsigned char* lds, const Gemm g, const Sched& S, const Epi& E) {
    const int tid = threadIdx.x, wid = __builtin_amdgcn_readfirstlane(tid >> 6), lane = tid & 63, wr = wid >> 2, wc = wid & 3, fr = lane & 15, fq = lane >> 4;
    const int K = g.K, nt = K / BK;
    unsigned voffA[2], voffB[2];
#pragma unroll
    for (int i = 0; i < 2; ++i) { int R, C; stage_rc(tid * 16 + i * 8192, R, C); const int Rb = Epi::PERM ? ((R & ~31) + perm32(R & 31)) : R;
        voffA[i] = (unsigned)(R * K + C) * 2u; voffB[i] = (unsigned)(Rb * K + C) * 2u; }
    const size_t kstep = (size_t)(BK * 2);
    const size_t hstep = (size_t)HALF * K * 2;
    const size_t tstep = 2 * hstep;
    const unsigned ldsw = (unsigned)wid * 1024u;
    const int aoff = lds_byte(wr * 64 + fr, fq * 8), boff = lds_byte(wc * 32 + fr, fq * 8);
#define PG8_SA(b, h) (((b) * 2 + (h)) * HTB)
#define PG8_SB(b, h) ((4 + (b) * 2 + (h)) * HTB)
#define PG8_STAGE(bufoff, gbase, voff) do { _Pragma("unroll") for (int _i = 0; _i < 2; ++_i) \
        __builtin_amdgcn_global_load_lds((const unsigned*)((const char*)(gbase) + (voff)[_i]), (PG8_LAS unsigned*)(lds + (bufoff) + ldsw + _i * 8192), 16, 0, 0); } while (0)
#define PG8_LDA(dst, b, h) do { _Pragma("unroll") for (int m = 0; m < 4; ++m) _Pragma("unroll") for (int k = 0; k < 2; ++k) dst[m][k] = *(const PG8_LAS bf16x8*)(lds + PG8_SA(b, h) + aoff + m * 2048 + k * 1024); } while (0)
#define PG8_LDB(dst, b, h) do { _Pragma("unroll") for (int n = 0; n < 2; ++n) _Pragma("unroll") for (int k = 0; k < 2; ++k) dst[n][k] = *(const PG8_LAS bf16x8*)(lds + PG8_SB(b, h) + boff + n * 2048 + k * 1024); } while (0)
#define PG8_MMA(ai, bj, At, Bt) do { __builtin_amdgcn_s_setprio(1); _Pragma("unroll") for (int m = 0; m < 4; ++m) _Pragma("unroll") for (int n = 0; n < 2; ++n) _Pragma("unroll") for (int k = 0; k < 2; ++k) \
        acc[ai][bj][m][n] = __builtin_amdgcn_mfma_f32_16x16x32_bf16(Bt[n][k], At[m][k], acc[ai][bj][m][n], 0, 0, 0); __builtin_amdgcn_s_setprio(0); } while (0)
#define PG8_WAIT_V(n) asm volatile("s_waitcnt vmcnt(" #n ")" ::: "memory")
#define PG8_WAIT_L(n) asm volatile("s_waitcnt lgkmcnt(" #n ")" ::: "memory")
#define PG8_BAR __builtin_amdgcn_s_barrier()
#define PG8_SCHED __builtin_amdgcn_sched_barrier(0)
    Unit cur, nxt; int ui = 0;
    if (!S.next(0, cur)) return;
    f32x4 acc[2][2][4][2];
#pragma unroll
    for (int a = 0; a < 2; ++a)
#pragma unroll
        for (int b = 0; b < 2; ++b)
#pragma unroll
            for (int m = 0; m < 4; ++m)
#pragma unroll
                for (int n = 0; n < 2; ++n) acc[a][b][m][n] = (f32x4){0.f, 0.f, 0.f, 0.f};
    bf16x8 At[4][2], B0[2][2], B1[2][2];
    const char* cA = (const char*)g.A + (size_t)cur.pm * tstep; const char* cB = (const char*)g.Bt + (size_t)cur.pn * tstep;
    S.a_ready(cur);
    if constexpr (SP2) {
        PG8_STAGE(PG8_SB(0, 0), cB, voffB); PG8_STAGE(PG8_SB(0, 1), cB + hstep, voffB); PG8_STAGE(PG8_SA(0, 0), cA, voffA); PG8_STAGE(PG8_SA(0, 1), cA + hstep, voffA);
        if (wr == 1) PG8_BAR;
        PG8_WAIT_V(2); PG8_BAR;
        PG8_STAGE(PG8_SB(1, 0), cB + kstep, voffB); PG8_STAGE(PG8_SA(1, 0), cA + kstep, voffA); PG8_STAGE(PG8_SB(1, 1), cB + hstep + kstep, voffB);
        PG8_WAIT_V(6); PG8_BAR;
    } else {
        PG8_STAGE(PG8_SB(0, 0), cB, voffB); PG8_STAGE(PG8_SA(0, 0), cA, voffA); PG8_STAGE(PG8_SB(0, 1), cB + hstep, voffB); PG8_STAGE(PG8_SA(0, 1), cA + hstep, voffA);
        if (wr == 1) PG8_BAR;
        PG8_WAIT_V(4); PG8_BAR;
        PG8_STAGE(PG8_SB(1, 0), cB + kstep, voffB); PG8_STAGE(PG8_SA(1, 0), cA + kstep, voffA); PG8_STAGE(PG8_SB(1, 1), cB + hstep + kstep, voffB);
        PG8_WAIT_V(6); PG8_BAR;
    }
    for (;;) {
        const bool has_next = S.next(ui + 1, nxt);
        const char* nA = has_next ? (const char*)g.A + (size_t)nxt.pm * tstep : cA; const char* nB = has_next ? (const char*)g.Bt + (size_t)nxt.pn * tstep : cB;
        for (int t = 0; t < nt; t += 2) {
            const bool last = (t == nt - 2);
            const char* a1 = cA + (size_t)(t + 1) * kstep;
            const char* a2 = last ? nA : cA + (size_t)(t + 2) * kstep; const char* b2 = last ? nB : cB + (size_t)(t + 2) * kstep;
            const char* a3 = a2 + kstep; const char* b3 = b2 + kstep;
            if (last && has_next) S.a_ready(nxt);
            if constexpr (SP2) {
            PG8_LDB(B0, 0, 0); PG8_LDB(B1, 0, 1); PG8_SCHED; PG8_LDA(At, 0, 0); PG8_STAGE(PG8_SA(1, 1), a1 + hstep, voffA);
            PG8_WAIT_V(8); PG8_WAIT_L(0); PG8_BAR; PG8_MMA(0, 0, At, B0); PG8_MMA(0, 1, At, B1); PG8_BAR; PG8_SCHED;
            PG8_LDA(At, 0, 1); PG8_STAGE(PG8_SB(0, 0), b2, voffB); PG8_STAGE(PG8_SB(0, 1), b2 + hstep, voffB); PG8_STAGE(PG8_SA(0, 0), a2, voffA);
            PG8_WAIT_V(8); PG8_WAIT_L(0); PG8_BAR; PG8_MMA(1, 0, At, B0); PG8_MMA(1, 1, At, B1); PG8_BAR; PG8_SCHED;
            PG8_LDB(B0, 1, 0); PG8_LDB(B1, 1, 1); PG8_SCHED; PG8_LDA(At, 1, 0); PG8_STAGE(PG8_SA(0, 1), a2 + hstep, voffA);
            PG8_WAIT_V(8); PG8_WAIT_L(0); PG8_BAR; PG8_MMA(0, 0, At, B0); PG8_MMA(0, 1, At, B1); PG8_BAR; PG8_SCHED;
            PG8_LDA(At, 1, 1); PG8_STAGE(PG8_SB(1, 0), b3, voffB); PG8_STAGE(PG8_SB(1, 1), b3 + hstep, voffB); PG8_STAGE(PG8_SA(1, 0), a3, voffA);
            PG8_WAIT_V(8); PG8_WAIT_L(0); PG8_BAR; PG8_MMA(1, 0, At, B0); PG8_MMA(1, 1, At, B1); PG8_BAR; PG8_SCHED;
            } else {
            PG8_LDB(B0, 0, 0); PG8_SCHED; PG8_LDA(At, 0, 0); PG8_STAGE(PG8_SA(1, 1), a1 + hstep, voffA);
            PG8_WAIT_L(8); PG8_BAR; PG8_WAIT_L(0); PG8_MMA(0, 0, At, B0); PG8_BAR; PG8_SCHED;
            PG8_LDB(B1, 0, 1); PG8_STAGE(PG8_SB(0, 0), b2, voffB);
            PG8_BAR; PG8_WAIT_L(0); PG8_MMA(0, 1, At, B1); PG8_BAR;
            PG8_LDA(At, 0, 1); PG8_STAGE(PG8_SA(0, 0), a2, voffA);
            PG8_BAR; PG8_WAIT_L(0); PG8_MMA(1, 0, At, B0); PG8_BAR; PG8_SCHED;
            PG8_STAGE(PG8_SB(0, 1), b2 + hstep, voffB);
            PG8_WAIT_V(6); PG8_BAR; PG8_MMA(1, 1, At, B1); PG8_BAR;
            PG8_LDB(B0, 1, 0); PG8_SCHED; PG8_LDA(At, 1, 0); PG8_STAGE(PG8_SA(0, 1), a2 + hstep, voffA);
            PG8_WAIT_L(8); PG8_BAR; PG8_WAIT_L(0); PG8_MMA(0, 0, At, B0); PG8_BAR; PG8_SCHED;
            PG8_LDB(B1, 1, 1); PG8_STAGE(PG8_SB(1, 0), b3, voffB);
            PG8_BAR; PG8_WAIT_L(0); PG8_MMA(0, 1, At, B1); PG8_BAR;
            PG8_LDA(At, 1, 1); PG8_STAGE(PG8_SA(1, 0), a3, voffA);
            PG8_BAR; PG8_WAIT_L(0); PG8_MMA(1, 0, At, B0); PG8_BAR; PG8_SCHED;
            PG8_STAGE(PG8_SB(1, 1), b3 + hstep, voffB);
            PG8_WAIT_V(6); PG8_BAR; PG8_MMA(1, 1, At, B1); PG8_BAR;
            }
        }
        if constexpr (ALIGN_EPI) { if (wr == 0) PG8_BAR; }
        if constexpr (!Epi::AFTER_DRAIN) { E(acc, cur, wr, wc, fr, fq); S.done(cur); }
        if (!has_next) break;
#pragma unroll
        for (int a = 0; a < 2; ++a)
#pragma unroll
            for (int b = 0; b < 2; ++b)
#pragma unroll
                for (int m = 0; m < 4; ++m)
#pragma unroll
                    for (int n = 0; n < 2; ++n) acc[a][b][m][n] = (f32x4){0.f, 0.f, 0.f, 0.f};
        cur = nxt; cA = nA; cB = nB; ++ui;
        if constexpr (ALIGN_EPI) { if (wr == 1) PG8_BAR; }
    }
    PG8_WAIT_V(0);
    if constexpr (!ALIGN_EPI) { if (wr == 0) PG8_BAR; }
    PG8_BAR;
    if constexpr (Epi::AFTER_DRAIN) { E.fused(acc, cur, wr, wc, fr, fq, lds, wid, lane); S.done(cur); }
#undef PG8_SA
#undef PG8_SB
#undef PG8_STAGE
#undef PG8_LDA
#undef PG8_LDB
#undef PG8_MMA
#undef PG8_WAIT_V
#undef PG8_WAIT_L
#undef PG8_BAR
#undef PG8_SCHED
}
}
#define XB_TMO      128
#define XB_XCNT(j)  (256  + 64 * (j))
#define XB_XSUB(j)  (1280 + 64 * (j))
#define XB_XGEN(j)  (2304 + 64 * (j))
#define XB_TOP      3328
#define XB_TOPGEN   3392
#define XCD_BAR_WORDS 3456
#define XB_SPIN_CAP (1u << 18)
#define LAS __attribute__((address_space(3)))

__device__ __forceinline__ unsigned xb_ld(unsigned* p)              { return __hip_atomic_load(p, __ATOMIC_RELAXED, __HIP_MEMORY_SCOPE_AGENT); }
__device__ __forceinline__ unsigned xb_add(unsigned* p, unsigned v) { return __hip_atomic_fetch_add(p, v, __ATOMIC_RELAXED, __HIP_MEMORY_SCOPE_AGENT); }
__device__ __forceinline__ unsigned xb_xcc_id() { return (unsigned)__builtin_amdgcn_s_getreg((3 << 11) | 20) & 0xFu; }
#define XB_SPIN(cond, bar) do { unsigned _sp = 0; while (cond) { __builtin_amdgcn_s_sleep(1); \
    if ((++_sp & 255u) == 0u) { if (xb_ld(&(bar)[XB_TMO])) break; if (_sp > XB_SPIN_CAP) { atomicAdd(&(bar)[XB_TMO], 1u); break; } } } } while (0)

struct XcdBarrier {
    unsigned* bar; unsigned x;
    volatile LAS unsigned* st;
};

__device__ __forceinline__ XcdBarrier xcd_barrier_post(unsigned* bar, volatile LAS unsigned* st) {
    XcdBarrier b; b.bar = bar; b.x = xb_xcc_id(); b.st = st;
    if (threadIdx.x == 0) (void)xb_add(&bar[XB_XCNT(b.x)], 1u);
    return b;
}
__device__ __forceinline__ void xcd_barrier_complete(unsigned* bar, unsigned x, unsigned& nloc, unsigned& nx) {
    const unsigned G = gridDim.x * gridDim.y * gridDim.z;
    unsigned sum, cnt, mine, sp = 0u;
    for (;;) {
        sum = 0u; cnt = 0u; mine = 0u;
#pragma unroll
        for (unsigned j = 0; j < 16; ++j) { const unsigned c = xb_ld(&bar[XB_XCNT(j)]); sum += c; cnt += (c > 0u) ? 1u : 0u; mine = (j == x) ? c : mine; }
        if (sum == G) break;
        __builtin_amdgcn_s_sleep(1);
        if ((++sp & 255u) == 0u) { if (xb_ld(&bar[XB_TMO])) break; if (sp > XB_SPIN_CAP) { atomicAdd(&bar[XB_TMO], 1u); break; } }
    }
    nloc = mine > 0u ? mine : 1u; nx = cnt > 0u ? cnt : 1u;
}

__device__ __forceinline__ void xcd_barrier(const XcdBarrier& b) {
    asm volatile("s_waitcnt vmcnt(0)" ::: "memory");
    __syncthreads();
    if (threadIdx.x == 0) {
        unsigned* bar = b.bar;
        __builtin_amdgcn_s_waitcnt(0);
        unsigned nloc = b.st[0], nx = b.st[1];
        if (nloc == 0u) { xcd_barrier_complete(bar, b.x, nloc, nx); b.st[0] = nloc; b.st[1] = nx; }
        const unsigned old = xb_add(&bar[XB_XSUB(b.x)], 1u);
        const unsigned gen = old / nloc;
        if (old + 1u == (gen + 1u) * nloc) {
            __builtin_amdgcn_fence(__ATOMIC_RELEASE, "agent");
            asm volatile("s_waitcnt vmcnt(0)" ::: "memory");
            const unsigned og = xb_add(&bar[XB_TOP], 1u);
            const unsigned tg = og / nx;
            if (og + 1u == (tg + 1u) * nx) xb_add(&bar[XB_TOPGEN], 1u);
            else XB_SPIN(xb_ld(&bar[XB_TOPGEN]) == tg, bar);
            __builtin_amdgcn_fence(__ATOMIC_ACQUIRE, "agent");
            xb_add(&bar[XB_XGEN(b.x)], 1u);
            asm volatile("s_waitcnt vmcnt(0)" ::: "memory");
        } else {
            XB_SPIN(xb_ld(&bar[XB_XGEN(b.x)]) == gen, bar);
            __builtin_amdgcn_fence(__ATOMIC_ACQUIRE, "agent");
            asm volatile("s_waitcnt vmcnt(0)" ::: "memory");
        }
    }
    __syncthreads();
}


typedef unsigned short bf16;
typedef short bf16x8 __attribute__((ext_vector_type(8)));
typedef float f32x4 __attribute__((ext_vector_type(4)));
typedef float f32x2 __attribute__((ext_vector_type(2)));
typedef unsigned u32x4 __attribute__((ext_vector_type(4)));
typedef unsigned u32x2 __attribute__((ext_vector_type(2)));

constexpr int D = 2048, MP = 8192, MS = 1024, M = MP + MS, DFF = 5632, NGU = 2 * DFF;
constexpr int SEQ = 2048, NB = 4, DB = 128, DSEQ = 8, PAST = 16384;
constexpr int RIN = 12288, RV = 4096;
constexpr int GIN = 12352, GINP = 12544;
constexpr int NMOD = 36864, LMOD = 18432, MODROWS = 256, NMB = 132;
constexpr int CONVCH = 8192;
constexpr float EPS = 1e-6f;
constexpr int NPH = 25;

constexpr size_t O_Y = 0, O_RETP = (size_t)M * D, O_RETS = O_RETP + (size_t)NB * 8 * 256 * 512, O_GDNP = O_RETS + (size_t)DB * 8 * 256 * 512,
                 O_GDNS = O_GDNP + (size_t)NB * 32 * 128 * 128, O_CONVP = O_GDNS + (size_t)DB * 32 * 128 * 128, O_CONVS = O_CONVP + (size_t)NB * 3 * CONVCH,
                 O_END = O_CONVS + (size_t)DB * 3 * CONVCH;

constexpr size_t MiB = 1u << 20;
constexpr size_t al(size_t x) { return (x + MiB - 1) / MiB * MiB; }
constexpr size_t WS_CTL = 0, CTL_BYTES = MiB;
constexpr size_t WS_WADA = WS_CTL + CTL_BYTES;
constexpr size_t WS_WGU = WS_WADA + al((size_t)NMOD * D * 2);
constexpr size_t SZ_WGU = (size_t)NGU * D * 2;
constexpr size_t WS_WDN = WS_WGU + al(4 * SZ_WGU);
constexpr size_t SZ_WDN = (size_t)D * DFF * 2;
constexpr size_t WS_WRI = WS_WDN + al(4 * SZ_WDN);
constexpr size_t WS_WRO = WS_WRI + al((size_t)RIN * D * 2);
constexpr size_t WS_WGI = WS_WRO + al((size_t)D * RV * 2);
constexpr size_t WS_WGO = WS_WGI + al((size_t)GINP * D * 2);
constexpr size_t WS_CS = WS_WGO + al((size_t)D * RV * 2);
constexpr size_t WS_MOD = WS_CS + al((size_t)MODROWS * D * 2);
constexpr size_t WS_ROT = WS_MOD + al((size_t)MODROWS * NMOD * 4);
constexpr size_t WS_H = WS_ROT + al((size_t)2056 * 128 * 8);
constexpr size_t WS_P = WS_H + al((size_t)M * D * 2);
constexpr size_t WS_Y = WS_P + al((size_t)M * GINP * 2);
constexpr size_t WS_OB = WS_Y + al((size_t)M * D * 4);
constexpr size_t WS_AO = WS_OB + al((size_t)M * RV * 4);
constexpr size_t WS_AB = WS_AO + al((size_t)M * RV * 2);
constexpr size_t WS_GL = WS_AB + al((size_t)M * 64 * 4);
constexpr size_t WS_F1 = WS_GL + MiB;
constexpr size_t F1_ITEM = 73728, F1_QG = 0, F1_W = 16384, F1_UT = 32768, F1_KDT = 49152, F1_ATT = 65536;
constexpr size_t WS_END = WS_F1 + al(4096 * F1_ITEM);

constexpr int LDS_BYTES = 160 * 1024;
constexpr int MISC_OFF = LDS_BYTES - 256;

__device__ __forceinline__ unsigned pk2(float lo, float hi) { return pg8::cvt_pk_bf16(lo, hi); }
__device__ __forceinline__ bf16 f2bf(float f) { return (bf16)(pk2(f, 0.f) & 0xffffu); }
__device__ __forceinline__ float bflo(unsigned w) { return __uint_as_float(w << 16); }
__device__ __forceinline__ float bfhi(unsigned w) { return __uint_as_float(w & 0xffff0000u); }
__device__ __forceinline__ float bf2f(bf16 b) { return __uint_as_float(((unsigned)b) << 16); }
__device__ __forceinline__ void unpack8(const u32x4 w, float (&f)[8]) { f[0] = bflo(w.x); f[1] = bfhi(w.x); f[2] = bflo(w.y); f[3] = bfhi(w.y); f[4] = bflo(w.z); f[5] = bfhi(w.z); f[6] = bflo(w.w); f[7] = bfhi(w.w); }
__device__ __forceinline__ u32x4 pack8(const float (&f)[8]) { u32x4 w; w.x = pk2(f[0], f[1]); w.y = pk2(f[2], f[3]); w.z = pk2(f[4], f[5]); w.w = pk2(f[6], f[7]); return w; }
__device__ __forceinline__ float wave_sum(float v) {
#pragma unroll
    for (int o = 1; o < 64; o <<= 1) v += __shfl_xor(v, o);
    return v;
}
__device__ __forceinline__ float silu_f(float x) { return x / (1.0f + __expf(-x)); }
__device__ __forceinline__ float sigmoid_f(float x) { return 1.0f / (1.0f + __expf(-x)); }
__device__ __forceinline__ float softplus_f(float x) { return fmaxf(x, 0.f) + log1pf(__expf(-fabsf(x))); }

template <int K>
__device__ __forceinline__ void mma_tile(f32x4& acc, const LAS bf16* X, int ldx, const LAS bf16* Y, int ldy, int lane) {
    const int r = lane & 15, kq = lane >> 4;
    const LAS bf16* xp = X + r * ldx + kq * 8;
    const LAS bf16* yp = Y + r * ldy + kq * 8;
#pragma unroll
    for (int k = 0; k < K; k += 32) {
        const bf16x8 a = *(const LAS bf16x8*)(xp + k);
        const bf16x8 b = *(const LAS bf16x8*)(yp + k);
        acc = __builtin_amdgcn_mfma_f32_16x16x32_bf16(a, b, acc, 0, 0, 0);
    }
}

__device__ __forceinline__ void sincos_d(double x, double& s, double& c) {
    const double k = rint(x * 0.63661977236758134308);
    double r = fma(-k, 1.57079632679489655800e+00, x);
    r = fma(-k, 6.12323399573676603587e-17, r);
    const double r2 = r * r;
    double ps = -1.0 / 1307674368000.0;
    ps = fma(ps, r2, 1.0 / 6227020800.0); ps = fma(ps, r2, -1.0 / 39916800.0); ps = fma(ps, r2, 1.0 / 362880.0); ps = fma(ps, r2, -1.0 / 5040.0);
    ps = fma(ps, r2, 1.0 / 120.0); ps = fma(ps, r2, -1.0 / 6.0); ps = fma(ps * r2, r, r);
    double pc = 1.0 / 20922789888000.0;
    pc = fma(pc, r2, -1.0 / 87178291200.0); pc = fma(pc, r2, 1.0 / 479001600.0); pc = fma(pc, r2, -1.0 / 3628800.0); pc = fma(pc, r2, 1.0 / 40320.0);
    pc = fma(pc, r2, -1.0 / 720.0); pc = fma(pc, r2, 1.0 / 24.0); pc = fma(pc, r2, -0.5); pc = fma(pc, r2, 1.0);
    const int q = ((int)k) & 3;
    s = (q == 0) ? ps : (q == 1) ? pc : (q == 2) ? -ps : -pc;
    c = (q == 0) ? pc : (q == 1) ? -ps : (q == 2) ? -pc : ps;
}

struct Args { const float* in[21]; float* out; unsigned char* ws; int ph_lo, ph_hi; };

struct Fr {
    LAS unsigned char* lds;
    int tid, lane, wave;
    const float* const* in;
    float* out; unsigned char* ws;
};

template <int MODE>
__device__ __forceinline__ void transpose_item(const float* W, int K, int N, bf16* WT, int row_off, LAS float* scr, int item, int lane) {
    const int nblk = N / 32, kb = item / nblk, nb = item % nblk, k0 = 64 * kb, n0 = 32 * nb;
#pragma unroll 8
    for (int i = 0; i < 32; ++i) { const int kk = 2 * i + (lane >> 5); scr[kk * 33 + (lane & 31)] = W[(size_t)(k0 + kk) * N + n0 + (lane & 31)]; }
    asm volatile("s_waitcnt lgkmcnt(0)" ::: "memory");
    const int c = lane & 7;
#pragma unroll
    for (int j = 0; j < 4; ++j) { const int n = (lane >> 3) + 8 * j; const LAS float* s = scr + (8 * c) * 33 + n;
        u32x4 o; o.x = pk2(s[0 * 33], s[1 * 33]); o.y = pk2(s[2 * 33], s[3 * 33]); o.z = pk2(s[4 * 33], s[5 * 33]); o.w = pk2(s[6 * 33], s[7 * 33]);
        int gn = n0 + n, drow;
        if (MODE == 0) drow = row_off + gn;
        else { const int up = gn >= DFF ? 1 : 0; const int nn = gn - up * DFF; drow = 32 * (nn >> 4) + 16 * up + (nn & 15); }
        *(u32x4*)(WT + (size_t)drow * K + k0 + 8 * c) = o; }
    asm volatile("s_waitcnt lgkmcnt(0)" ::: "memory");
}
template <int MODE>
__device__ __forceinline__ void transpose_all(const float* W, int K, int N, bf16* WT, int row_off, LAS float* scr, int gw, int NGW, int lane) {
    const int ni = (K / 64) * (N / 32);
    for (int it = gw; it < ni; it += NGW) transpose_item<MODE>(W, K, N, WT, row_off, scr, it, lane);
}

__device__ __forceinline__ void prep_phase(const Args& a, LAS unsigned char* lds, int tid, int lane, int wave) {
    LAS float* scr = (LAS float*)(lds + wave * 8448);
    const int gw = blockIdx.x * 8 + wave, NGW = gridDim.x * 8;
    unsigned char* ws = a.ws;
    transpose_all<0>(a.in[7], D, LMOD, (bf16*)(ws + WS_WADA), 0, scr, gw, NGW, lane);
    transpose_all<0>(a.in[7] + (size_t)D * LMOD, D, LMOD, (bf16*)(ws + WS_WADA), LMOD, scr, gw, NGW, lane);
#pragma unroll 1
    for (int i = 0; i < 4; ++i) {
        transpose_all<1>(a.in[11] + (size_t)i * D * NGU, D, NGU, (bf16*)(ws + WS_WGU + i * SZ_WGU), 0, scr, gw, NGW, lane);
        transpose_all<0>(a.in[12] + (size_t)i * DFF * D, DFF, D, (bf16*)(ws + WS_WDN + i * SZ_WDN), 0, scr, gw, NGW, lane);
    }
    transpose_all<0>(a.in[13], D, RIN, (bf16*)(ws + WS_WRI), 0, scr, gw, NGW, lane);
    transpose_all<0>(a.in[14], RV, D, (bf16*)(ws + WS_WRO), 0, scr, gw, NGW, lane);
    transpose_all<0>(a.in[15], D, GIN, (bf16*)(ws + WS_WGI), 0, scr, gw, NGW, lane);
    transpose_all<0>(a.in[20], RV, D, (bf16*)(ws + WS_WGO), 0, scr, gw, NGW, lane);
    const size_t gt = (size_t)blockIdx.x * 512 + tid, GT = (size_t)gridDim.x * 512;
    { unsigned* z = (unsigned*)(ws + WS_WGI + (size_t)GIN * D * 2); const size_t nz = (size_t)(GINP - GIN) * D / 2; for (size_t i = gt; i < nz; i += GT) z[i] = 0u; }
    { bf16* cs = (bf16*)(ws + WS_CS); const float* cp = a.in[2]; const float* csm = a.in[3];
      for (size_t i = gt; i < (size_t)MODROWS * D; i += GT) { const int row = (int)(i / D), col = (int)(i % D); float v = 0.f;
          if (row < NB) v = silu_f(cp[(size_t)row * D + col]); else if (row < NMB) v = silu_f(csm[(size_t)(row - NB) * D + col]);
          cs[i] = f2bf(v); } }
    { f32x2* rot = (f32x2*)(ws + WS_ROT);
      for (size_t i = gt; i < (size_t)2056 * 128; i += GT) { const int p = (int)(i >> 7), j = (int)(i & 127); const int pos = p < SEQ ? p : PAST + (p - SEQ);
          const float t = (float)j / 127.0f; const float pw = (float)exp((double)t * 9.210340371976184); const float inv = 1.0f / pw;
          const float ang = (float)pos * inv; double s, c; sincos_d((double)ang, s, c); rot[i] = (f32x2){(float)c, (float)s}; } }
}

template <bool FIRST_SRC, bool HAS_Y, bool HAS_NEXT>
__device__ __forceinline__ void thin_phase(const float* xp, const float* xs, float* out, const float* y, const float* mod, const float* wpost, int off_gate, float res_scale,
                                           const float* wpre, int off_shift, bf16* h, int lane, int wave) {
    const int gw = blockIdx.x * 8 + wave, NGW = gridDim.x * 8;
    for (int r = gw; r < M; r += NGW) {
        const float* xr = FIRST_SRC ? (r < MP ? xp + (size_t)r * D : xs + (size_t)(r - MP) * D) : out + (size_t)r * D;
        const int mb = r < MP ? (r >> 11) : NB + ((r - MP) >> 3);
        const float* modr = mod + (size_t)mb * NMOD;
        f32x4 x[8];
#pragma unroll
        for (int j = 0; j < 8; ++j) x[j] = *(const f32x4*)(xr + 4 * lane + 256 * j);
        if (HAS_Y) {
            f32x4 yv[8]; float ss = 0.f;
#pragma unroll
            for (int j = 0; j < 8; ++j) { yv[j] = *(const f32x4*)(y + (size_t)r * D + 4 * lane + 256 * j); ss += (yv[j][0] * yv[j][0] + yv[j][1] * yv[j][1]) + (yv[j][2] * yv[j][2] + yv[j][3] * yv[j][3]); }
            ss = wave_sum(ss); const float rstd = 1.0f / sqrtf(ss * (1.0f / D) + EPS);
#pragma unroll
            for (int j = 0; j < 8; ++j) { const int c = 4 * lane + 256 * j; const f32x4 g = *(const f32x4*)(modr + off_gate + c), w = *(const f32x4*)(wpost + c);
                x[j] = x[j] + (res_scale * g) * (yv[j] * rstd * w); *(f32x4*)(out + (size_t)r * D + c) = x[j]; }
        }
        if (HAS_NEXT) {
            float ss = 0.f;
#pragma unroll
            for (int j = 0; j < 8; ++j) ss += (x[j][0] * x[j][0] + x[j][1] * x[j][1]) + (x[j][2] * x[j][2] + x[j][3] * x[j][3]);
            ss = wave_sum(ss); const float rstd = 1.0f / sqrtf(ss * (1.0f / D) + EPS);
#pragma unroll
            for (int j = 0; j < 8; ++j) { const int c = 4 * lane + 256 * j; const f32x4 sh = *(const f32x4*)(modr + off_shift + c), sc = *(const f32x4*)(modr + off_shift + D + c), w = *(const f32x4*)(wpre + c);
                const f32x4 hv = (x[j] * rstd * w) * (1.0f + sc) + sh; u32x2 o; o.x = pk2(hv[0], hv[1]); o.y = pk2(hv[2], hv[3]); *(u32x2*)(h + (size_t)r * D + c) = o; }
        }
    }
}

__device__ __forceinline__ void ret_prompt_item(int it, const bf16* P, const f32x2* ROT, float* OB, float* retp, LAS unsigned char* lds, int tid, int lane, int wave) {
    const int b = it >> 6, h = (it >> 3) & 7, vs = it & 7;
    LAS bf16* Qs = (LAS bf16*)lds;
    LAS bf16* Ks = Qs + 64 * 264;
    LAS bf16* STs = Ks + 64 * 264;
    LAS bf16* KTs = STs + 64 * 264;
    LAS bf16* VTs = KTs + 256 * 72;
    LAS bf16* SCs = VTs + 64 * 72;
    const float lg = log1pf(-exp2f(-5.0f - (float)h));
    const float cd = __expf(lg * 64.0f);
    f32x4 accS[8];
#pragma unroll
    for (int e = 0; e < 8; ++e) accS[e] = (f32x4){0.f, 0.f, 0.f, 0.f};
    const int fr = lane & 15, fq = lane >> 4;
    for (int n = 0; n < 32; ++n) {
        const int r0 = b * SEQ + n * 64;
#pragma unroll
        for (int e = 0; e < 8; ++e) { const int T = wave * 8 + e, dt = T >> 2, vt = T & 3; u32x2 w; w.x = pk2(accS[e][0], accS[e][1]); w.y = pk2(accS[e][2], accS[e][3]);
            *(LAS u32x2*)(STs + (16 * vt + fr) * 264 + 16 * dt + 4 * fq) = w; }
#pragma unroll 1
        for (int i = 0; i < 4; ++i) { const int idx = tid + 512 * i, which = idx >> 10, rem = idx & 1023, row = rem >> 4, d0 = (rem & 15) * 8;
            const bf16* src = P + (size_t)(r0 + row) * RIN + which * 2048 + h * 256;
            float x1[8], x2[8], y1[8], y2[8]; unpack8(*(const u32x4*)(src + d0), x1); unpack8(*(const u32x4*)(src + 128 + d0), x2);
            const f32x4* rt = (const f32x4*)(ROT + (size_t)(n * 64 + row) * 128 + d0);
#pragma unroll
            for (int j2 = 0; j2 < 4; ++j2) { const f32x4 cs = rt[j2];
                y1[2 * j2] = x1[2 * j2] * cs[0] - x2[2 * j2] * cs[1]; y2[2 * j2] = x1[2 * j2] * cs[1] + x2[2 * j2] * cs[0];
                y1[2 * j2 + 1] = x1[2 * j2 + 1] * cs[2] - x2[2 * j2 + 1] * cs[3]; y2[2 * j2 + 1] = x1[2 * j2 + 1] * cs[3] + x2[2 * j2 + 1] * cs[2]; }
            if (which == 0) {
#pragma unroll
                for (int j = 0; j < 8; ++j) { y1[j] *= 0.0625f; y2[j] *= 0.0625f; }
                *(LAS u32x4*)(Qs + row * 264 + d0) = pack8(y1); *(LAS u32x4*)(Qs + row * 264 + 128 + d0) = pack8(y2);
            } else {
                *(LAS u32x4*)(Ks + row * 264 + d0) = pack8(y1); *(LAS u32x4*)(Ks + row * 264 + 128 + d0) = pack8(y2);
                const float kd = __expf(lg * (float)(63 - row));
#pragma unroll
                for (int j = 0; j < 8; ++j) { KTs[(d0 + j) * 72 + row] = f2bf(y1[j] * kd); KTs[(128 + d0 + j) * 72 + row] = f2bf(y2[j] * kd); }
            } }
        { const int row = tid >> 3, g8 = (tid & 7) * 8; const u32x4 vv = *(const u32x4*)(P + (size_t)(r0 + row) * RIN + 4096 + h * 512 + vs * 64 + g8);
          VTs[(g8 + 0) * 72 + row] = (bf16)(vv.x & 0xffffu); VTs[(g8 + 1) * 72 + row] = (bf16)(vv.x >> 16); VTs[(g8 + 2) * 72 + row] = (bf16)(vv.y & 0xffffu); VTs[(g8 + 3) * 72 + row] = (bf16)(vv.y >> 16);
          VTs[(g8 + 4) * 72 + row] = (bf16)(vv.z & 0xffffu); VTs[(g8 + 5) * 72 + row] = (bf16)(vv.z >> 16); VTs[(g8 + 6) * 72 + row] = (bf16)(vv.w & 0xffffu); VTs[(g8 + 7) * 72 + row] = (bf16)(vv.w >> 16); }
        __syncthreads();
#pragma unroll
        for (int e = 0; e < 2; ++e) { const int t = wave * 2 + e, itile = t >> 2, jtile = t & 3; f32x4 acc = (f32x4){0.f, 0.f, 0.f, 0.f};
            mma_tile<256>(acc, Ks + jtile * 16 * 264, 264, Qs + itile * 16 * 264, 264, lane);
            const int i = 16 * itile + fr, j0 = 16 * jtile + 4 * fq; float v[4];
#pragma unroll
            for (int ii = 0; ii < 4; ++ii) { const int j = j0 + ii; v[ii] = (i >= j) ? acc[ii] * __expf(lg * (float)(i - j)) : 0.f; }
            u32x2 w; w.x = pk2(v[0], v[1]); w.y = pk2(v[2], v[3]); *(LAS u32x2*)(SCs + i * 72 + j0) = w; }
        __syncthreads();
#pragma unroll
        for (int e = 0; e < 2; ++e) { const int t = wave * 2 + e, vt = t >> 2, itile = t & 3; f32x4 intra = (f32x4){0.f, 0.f, 0.f, 0.f}, inter = (f32x4){0.f, 0.f, 0.f, 0.f};
            mma_tile<64>(intra, VTs + vt * 16 * 72, 72, SCs + itile * 16 * 72, 72, lane);
            mma_tile<256>(inter, STs + vt * 16 * 264, 264, Qs + itile * 16 * 264, 264, lane);
            const int i = 16 * itile + fr, v0 = 16 * vt + 4 * fq; const float qd = __expf(lg * (float)(i + 1));
            *(f32x4*)(OB + (size_t)(r0 + i) * RV + h * 512 + vs * 64 + v0) = intra + qd * inter; }
#pragma unroll
        for (int e = 0; e < 8; ++e) { const int T = wave * 8 + e, dt = T >> 2, vt = T & 3; accS[e] = accS[e] * cd;
            mma_tile<64>(accS[e], KTs + dt * 16 * 72, 72, VTs + vt * 16 * 72, 72, lane); }
        __syncthreads();
    }
#pragma unroll
    for (int e = 0; e < 8; ++e) { const int T = wave * 8 + e, dt = T >> 2, vt = T & 3;
#pragma unroll
        for (int ii = 0; ii < 4; ++ii) retp[((size_t)(b * 8 + h) * 256 + 16 * dt + 4 * fq + ii) * 512 + vs * 64 + 16 * vt + fr] = accS[e][ii]; }
}

__device__ __forceinline__ void ret_sample_item(int it, const bf16* P, const f32x2* ROT, const float* S0, float* OB, float* rets, LAS unsigned char* lds, int tid, int lane, int wave) {
    const int b = it >> 3, h = it & 7;
    LAS float* QsT = (LAS float*)lds;
    LAS float* KdT = QsT + 2048;
    LAS float* Qf = KdT + 2048;
    LAS float* Kf = Qf + 2048;
    LAS float* As = Kf + 2048;
    LAS float* red = As + 64;
    const float lg = log1pf(-exp2f(-5.0f - (float)h));
    const int rbase = MP + b * DSEQ;
#pragma unroll 1
    for (int i = 0; i < 4; ++i) { const int idx = tid + 512 * i, which = idx >> 10, rem = idx & 1023, n = rem >> 7, j = rem & 127;
        const bf16* src = P + (size_t)(rbase + n) * RIN + which * 2048 + h * 256;
        const float x1 = bf2f(src[j]), x2 = bf2f(src[128 + j]); const f32x2 cs = ROT[(size_t)(SEQ + n) * 128 + j];
        float y1 = x1 * cs[0] - x2 * cs[1], y2 = x1 * cs[1] + x2 * cs[0];
        if (which == 0) { y1 *= 0.0625f; y2 *= 0.0625f; QsT[j * 8 + n] = y1; QsT[(128 + j) * 8 + n] = y2; Qf[n * 256 + j] = y1; Qf[n * 256 + 128 + j] = y2; }
        else { const float kd = __expf(lg * (float)(7 - n)); KdT[j * 8 + n] = y1 * kd; KdT[(128 + j) * 8 + n] = y2 * kd; Kf[n * 256 + j] = y1; Kf[n * 256 + 128 + j] = y2; } }
    const int vq = tid & 127, dg = tid >> 7;
    f32x4 vreg[8];
#pragma unroll
    for (int n = 0; n < 8; ++n) { const u32x2 w = *(const u32x2*)(P + (size_t)(rbase + n) * RIN + 4096 + h * 512 + 4 * vq); vreg[n] = (f32x4){bflo(w.x), bfhi(w.x), bflo(w.y), bfhi(w.y)}; }
    __syncthreads();
    { const int p = tid >> 3, part = tid & 7, n = p >> 3, m = p & 7; float s = 0.f;
#pragma unroll 8
      for (int d = 0; d < 32; ++d) s += Qf[n * 256 + part * 32 + d] * Kf[m * 256 + part * 32 + d];
      s += __shfl_xor(s, 1); s += __shfl_xor(s, 2); s += __shfl_xor(s, 4);
      if (part == 0) As[n * 8 + m] = (m <= n) ? s * __expf(lg * (float)(n - m)) : 0.f; }
    __syncthreads();
    f32x4 oi[8];
#pragma unroll
    for (int n = 0; n < 8; ++n) oi[n] = (f32x4){0.f, 0.f, 0.f, 0.f};
    const float g8 = __expf(lg * 8.0f);
    const float* sp = S0 + ((size_t)(b * 8 + h) * 256 + dg * 64) * 512 + 4 * vq;
    float* dp = rets + ((size_t)(b * 8 + h) * 256 + dg * 64) * 512 + 4 * vq;
#pragma unroll 4
    for (int dd = 0; dd < 64; ++dd) { const int d = dg * 64 + dd;
        const f32x4 s4 = *(const f32x4*)(sp + (size_t)dd * 512);
        const f32x4 qa = *(const LAS f32x4*)(QsT + d * 8), qb = *(const LAS f32x4*)(QsT + d * 8 + 4), ka = *(const LAS f32x4*)(KdT + d * 8), kb = *(const LAS f32x4*)(KdT + d * 8 + 4);
        f32x4 sn = s4 * g8;
#pragma unroll
        for (int n = 0; n < 4; ++n) { oi[n] += qa[n] * s4; oi[n + 4] += qb[n] * s4; sn += ka[n] * vreg[n]; sn += kb[n] * vreg[n + 4]; }
        *(f32x4*)(dp + (size_t)dd * 512) = sn; }
#pragma unroll
    for (int n = 0; n < 8; ++n) *(LAS f32x4*)(red + (dg * 8 + n) * 512 + 4 * vq) = oi[n];
    __syncthreads();
#pragma unroll
    for (int nn = 0; nn < 2; ++nn) { const int n = 2 * dg + nn;
        f32x4 o = *(const LAS f32x4*)(red + (0 * 8 + n) * 512 + 4 * vq) + *(const LAS f32x4*)(red + (1 * 8 + n) * 512 + 4 * vq) + *(const LAS f32x4*)(red + (2 * 8 + n) * 512 + 4 * vq) + *(const LAS f32x4*)(red + (3 * 8 + n) * 512 + 4 * vq);
        o = o * __expf(lg * (float)(n + 1));
#pragma unroll
        for (int m = 0; m < 8; ++m) o += As[n * 8 + m] * vreg[m];
        *(f32x4*)(OB + (size_t)(rbase + n) * RV + h * 512 + 4 * vq) = o; }
    __syncthreads();
}

__device__ __forceinline__ void ret_norm_phase(const float* OB, const bf16* P, bf16* AO, int lane, int wave) {
    const int gw = blockIdx.x * 8 + wave, NGW = gridDim.x * 8;
    for (int it = gw; it < M * 8; it += NGW) { const int r = it >> 3, h = it & 7;
        const float* op = OB + (size_t)r * RV + h * 512; const bf16* gp = P + (size_t)r * RIN + 8192 + h * 512;
        const f32x4 o0 = *(const f32x4*)(op + 4 * lane), o1 = *(const f32x4*)(op + 256 + 4 * lane);
        const u32x2 g0 = *(const u32x2*)(gp + 4 * lane), g1 = *(const u32x2*)(gp + 256 + 4 * lane);
        float ss = (o0[0] * o0[0] + o0[1] * o0[1]) + (o0[2] * o0[2] + o0[3] * o0[3]) + (o1[0] * o1[0] + o1[1] * o1[1]) + (o1[2] * o1[2] + o1[3] * o1[3]);
        ss = wave_sum(ss); const float rstd = 1.0f / sqrtf(ss * (1.0f / 512.0f) + EPS);
        u32x2 w0, w1;
        w0.x = pk2(silu_f(bflo(g0.x)) * o0[0] * rstd, silu_f(bfhi(g0.x)) * o0[1] * rstd); w0.y = pk2(silu_f(bflo(g0.y)) * o0[2] * rstd, silu_f(bfhi(g0.y)) * o0[3] * rstd);
        w1.x = pk2(silu_f(bflo(g1.x)) * o1[0] * rstd, silu_f(bfhi(g1.x)) * o1[1] * rstd); w1.y = pk2(silu_f(bflo(g1.y)) * o1[2] * rstd, silu_f(bfhi(g1.y)) * o1[3] * rstd);
        bf16* ap = AO + (size_t)r * RV + h * 512;
        *(u32x2*)(ap + 4 * lane) = w0; *(u32x2*)(ap + 256 + 4 * lane) = w1; }
}

__device__ __forceinline__ void gdn_f1_item(int it, const bf16* P, const float* AB, const float* convw, const float* alog, const float* dtb, unsigned char* f1buf, float* GL,
                                            LAS unsigned char* lds, int tid, int lane, int wave) {
    const int n = it & 31, hv = (it >> 5) & 31, b = it >> 10, hk = hv >> 1;
    const int r0 = b * SEQ + n * 64;
    LAS float* Qf = (LAS float*)lds;
    LAS float* Kf = Qf + 64 * 128;
    LAS float* Lf = (LAS float*)lds;
    LAS bf16* TB = (LAS bf16*)(lds + 64 * 68 * 4);
    LAS bf16* QN = (LAS bf16*)(lds + 65536);
    LAS bf16* KN = QN + 64 * 136;
    LAS bf16* VBT = KN + 64 * 136;
    LAS bf16* KBGT = VBT + 128 * 72;
    LAS float* gcs = (LAS float*)(KBGT + 128 * 72);
    LAS float* bts = gcs + 64;
    unsigned char* ib = f1buf + (size_t)it * F1_ITEM;
    bf16* gQG = (bf16*)(ib + F1_QG); bf16* gW = (bf16*)(ib + F1_W); bf16* gUT = (bf16*)(ib + F1_UT); bf16* gKDT = (bf16*)(ib + F1_KDT); bf16* gATT = (bf16*)(ib + F1_ATT);
    const int fr = lane & 15, fq = lane >> 4;
    if (wave == 0) { const float av = AB[(size_t)(r0 + lane) * 64 + hv], bv = AB[(size_t)(r0 + lane) * 64 + 32 + hv];
        float g = -__expf(alog[hv]) * softplus_f(av + dtb[hv]);
#pragma unroll
        for (int o = 1; o < 64; o <<= 1) { const float t = __shfl_up(g, o); if (lane >= o) g += t; }
        gcs[lane] = g; bts[lane] = sigmoid_f(bv);
        if (lane == 63) GL[it] = __expf(g); }
    __syncthreads();
#pragma unroll 1
    for (int i = 0; i < 6; ++i) { const int idx = tid + 512 * i, c = idx / 48, gi = idx % 48, ct = gi >> 4, g8 = (gi & 15) * 8;
        const int ch0 = (ct == 0 ? hk * 128 : ct == 1 ? 2048 + hk * 128 : 4096 + hv * 128) + g8;
        float acc[8];
#pragma unroll
        for (int j = 0; j < 8; ++j) acc[j] = 0.f;
#pragma unroll
        for (int tap = 0; tap < 4; ++tap) { const int tt = n * 64 + c - 3 + tap;
            if (tt >= 0) { float xv[8]; unpack8(*(const u32x4*)(P + (size_t)(b * SEQ + tt) * GINP + ch0), xv);
                const f32x4 w0 = *(const f32x4*)(convw + tap * CONVCH + ch0), w1 = *(const f32x4*)(convw + tap * CONVCH + ch0 + 4);
#pragma unroll
                for (int j = 0; j < 4; ++j) { acc[j] += xv[j] * w0[j]; acc[4 + j] += xv[4 + j] * w1[j]; } } }
#pragma unroll
        for (int j = 0; j < 8; ++j) acc[j] = silu_f(acc[j]);
        if (ct == 0) { *(LAS f32x4*)(Qf + c * 128 + g8) = (f32x4){acc[0], acc[1], acc[2], acc[3]}; *(LAS f32x4*)(Qf + c * 128 + g8 + 4) = (f32x4){acc[4], acc[5], acc[6], acc[7]}; }
        else if (ct == 1) { *(LAS f32x4*)(Kf + c * 128 + g8) = (f32x4){acc[0], acc[1], acc[2], acc[3]}; *(LAS f32x4*)(Kf + c * 128 + g8 + 4) = (f32x4){acc[4], acc[5], acc[6], acc[7]}; }
        else { const float bt = bts[c];
#pragma unroll
            for (int j = 0; j < 8; ++j) VBT[(g8 + j) * 72 + c] = f2bf(acc[j] * bt); } }
    __syncthreads();
    { const int c = tid >> 3, part = tid & 7; float q[16], k[16]; float sq = 0.f, sk = 0.f;
#pragma unroll
      for (int j = 0; j < 16; ++j) { q[j] = Qf[c * 128 + part * 16 + j]; k[j] = Kf[c * 128 + part * 16 + j]; sq += q[j] * q[j]; sk += k[j] * k[j]; }
      sq += __shfl_xor(sq, 1); sq += __shfl_xor(sq, 2); sq += __shfl_xor(sq, 4); sk += __shfl_xor(sk, 1); sk += __shfl_xor(sk, 2); sk += __shfl_xor(sk, 4);
      const float rq = (1.0f / sqrtf(sq + EPS)) * 0.08838834764831845f, rk = 1.0f / sqrtf(sk + EPS);
      const float gc = gcs[c], bt = bts[c], eg = __expf(gc), egl = __expf(gcs[63] - gc);
      float qn[16], kn[16], qg[16];
#pragma unroll
      for (int j = 0; j < 16; ++j) { qn[j] = q[j] * rq; kn[j] = k[j] * rk; qg[j] = qn[j] * eg; }
      u32x4 w;
      w.x = pk2(qn[0], qn[1]); w.y = pk2(qn[2], qn[3]); w.z = pk2(qn[4], qn[5]); w.w = pk2(qn[6], qn[7]); *(LAS u32x4*)(QN + c * 136 + part * 16) = w;
      w.x = pk2(qn[8], qn[9]); w.y = pk2(qn[10], qn[11]); w.z = pk2(qn[12], qn[13]); w.w = pk2(qn[14], qn[15]); *(LAS u32x4*)(QN + c * 136 + part * 16 + 8) = w;
      w.x = pk2(kn[0], kn[1]); w.y = pk2(kn[2], kn[3]); w.z = pk2(kn[4], kn[5]); w.w = pk2(kn[6], kn[7]); *(LAS u32x4*)(KN + c * 136 + part * 16) = w;
      w.x = pk2(kn[8], kn[9]); w.y = pk2(kn[10], kn[11]); w.z = pk2(kn[12], kn[13]); w.w = pk2(kn[14], kn[15]); *(LAS u32x4*)(KN + c * 136 + part * 16 + 8) = w;
      w.x = pk2(qg[0], qg[1]); w.y = pk2(qg[2], qg[3]); w.z = pk2(qg[4], qg[5]); w.w = pk2(qg[6], qg[7]); *(u32x4*)(gQG + c * 128 + part * 16) = w;
      w.x = pk2(qg[8], qg[9]); w.y = pk2(qg[10], qg[11]); w.z = pk2(qg[12], qg[13]); w.w = pk2(qg[14], qg[15]); *(u32x4*)(gQG + c * 128 + part * 16 + 8) = w;
#pragma unroll
      for (int j = 0; j < 16; ++j) { KBGT[(part * 16 + j) * 72 + c] = f2bf(kn[j] * bt * eg); gKDT[(part * 16 + j) * 64 + c] = f2bf(kn[j] * egl); } }
    __syncthreads();
#pragma unroll
    for (int e = 0; e < 2; ++e) { const int t = wave * 2 + e, itile = t >> 2, jtile = t & 3; f32x4 kk = (f32x4){0.f, 0.f, 0.f, 0.f}, qk = (f32x4){0.f, 0.f, 0.f, 0.f};
        mma_tile<128>(kk, KN + jtile * 16 * 136, 136, KN + itile * 16 * 136, 136, lane);
        mma_tile<128>(qk, KN + jtile * 16 * 136, 136, QN + itile * 16 * 136, 136, lane);
        const int i = 16 * itile + fr, j0 = 16 * jtile + 4 * fq; const float gi = gcs[i], bi = bts[i]; float lv[4], av[4];
#pragma unroll
        for (int ii = 0; ii < 4; ++ii) { const int j = j0 + ii; const float dec = (j <= i) ? __expf(gi - gcs[j]) : 0.f; lv[ii] = (j < i) ? bi * kk[ii] * dec : 0.f; av[ii] = qk[ii] * dec; }
        *(LAS f32x4*)(Lf + i * 68 + j0) = (f32x4){lv[0], lv[1], lv[2], lv[3]};
        u32x2 w; w.x = pk2(av[0], av[1]); w.y = pk2(av[2], av[3]); *(u32x2*)(gATT + i * 64 + j0) = w; }
    __syncthreads();
    if (wave == 0) { float Tc[64];
#pragma unroll
        for (int i = 0; i < 64; ++i) { float s0 = (lane == i) ? 1.f : 0.f, s1 = 0.f, s2 = 0.f, s3 = 0.f;
#pragma unroll
            for (int k = 0; k < i; ++k) { const float l = Lf[i * 68 + k];
                if ((k & 3) == 0) s0 -= l * Tc[k]; else if ((k & 3) == 1) s1 -= l * Tc[k]; else if ((k & 3) == 2) s2 -= l * Tc[k]; else s3 -= l * Tc[k]; }
            Tc[i] = (s0 + s1) + (s2 + s3);
            TB[i * 72 + lane] = f2bf(Tc[i]); } }
    __syncthreads();
#pragma unroll
    for (int e = 0; e < 4; ++e) { const int t = wave * 4 + e, itile = t & 3, vt = t >> 2; f32x4 acc = (f32x4){0.f, 0.f, 0.f, 0.f};
        mma_tile<64>(acc, TB + itile * 16 * 72, 72, VBT + vt * 16 * 72, 72, lane);
        u32x2 w; w.x = pk2(acc[0], acc[1]); w.y = pk2(acc[2], acc[3]); *(u32x2*)(gUT + (16 * vt + fr) * 64 + 16 * itile + 4 * fq) = w;
        f32x4 acc2 = (f32x4){0.f, 0.f, 0.f, 0.f};
        mma_tile<64>(acc2, KBGT + vt * 16 * 72, 72, TB + itile * 16 * 72, 72, lane);
        w.x = pk2(acc2[0], acc2[1]); w.y = pk2(acc2[2], acc2[3]); *(u32x2*)(gW + (16 * itile + fr) * 128 + 16 * vt + 4 * fq) = w; }
    __syncthreads();
}

__device__ __forceinline__ void gdn_f2_item(int it, const unsigned char* f1buf, const float* GL, const bf16* P, const float* normw, bf16* AO, float* gdnp,
                                            LAS unsigned char* lds, int tid, int lane, int wave) {
    const int b = it >> 5, hv = it & 31;
    LAS bf16* STs = (LAS bf16*)lds;
    LAS bf16* Ws = STs + 128 * 136;
    LAS bf16* QGs = Ws + 64 * 136;
    LAS bf16* ATs = QGs + 64 * 136;
    LAS bf16* KDTs = ATs + 64 * 72;
    LAS bf16* VNTs = KDTs + 128 * 72;
    LAS float* Os = (LAS float*)(VNTs + 128 * 72);
    const int fr = lane & 15, fq = lane >> 4;
    f32x4 accS[8];
#pragma unroll
    for (int e = 0; e < 8; ++e) accS[e] = (f32x4){0.f, 0.f, 0.f, 0.f};
    for (int n = 0; n < 32; ++n) {
        const int item = it * 32 + n; const unsigned char* ib = f1buf + (size_t)item * F1_ITEM;
        const int r0 = b * SEQ + n * 64;
        const float gl = GL[item];
        { const u32x4* s;
          s = (const u32x4*)(ib + F1_W);
#pragma unroll
          for (int i = 0; i < 2; ++i) { const int idx = tid + 512 * i, row = idx >> 4, c8 = (idx & 15) * 8; *(LAS u32x4*)(Ws + row * 136 + c8) = s[idx]; }
          s = (const u32x4*)(ib + F1_QG);
#pragma unroll
          for (int i = 0; i < 2; ++i) { const int idx = tid + 512 * i, row = idx >> 4, c8 = (idx & 15) * 8; *(LAS u32x4*)(QGs + row * 136 + c8) = s[idx]; }
          s = (const u32x4*)(ib + F1_KDT);
#pragma unroll
          for (int i = 0; i < 2; ++i) { const int idx = tid + 512 * i, row = idx >> 3, c8 = (idx & 7) * 8; *(LAS u32x4*)(KDTs + row * 72 + c8) = s[idx]; }
          s = (const u32x4*)(ib + F1_ATT);
          { const int idx = tid, row = idx >> 3, c8 = (idx & 7) * 8; *(LAS u32x4*)(ATs + row * 72 + c8) = s[idx]; } }
#pragma unroll
        for (int e = 0; e < 8; ++e) { const int T = wave * 8 + e, dt = T >> 3, vt = T & 7; u32x2 w; w.x = pk2(accS[e][0], accS[e][1]); w.y = pk2(accS[e][2], accS[e][3]);
            *(LAS u32x2*)(STs + (16 * vt + fr) * 136 + 16 * dt + 4 * fq) = w; }
        __syncthreads();
        const bf16* gUT = (const bf16*)(ib + F1_UT);
#pragma unroll
        for (int e = 0; e < 4; ++e) { const int t = wave * 4 + e, ctile = t & 3, vt = t >> 2; f32x4 acc = (f32x4){0.f, 0.f, 0.f, 0.f};
            mma_tile<128>(acc, Ws + ctile * 16 * 136, 136, STs + vt * 16 * 136, 136, lane);
            const u32x2 uw = *(const u32x2*)(gUT + (16 * vt + fr) * 64 + 16 * ctile + 4 * fq);
            u32x2 w; w.x = pk2(bflo(uw.x) - acc[0], bfhi(uw.x) - acc[1]); w.y = pk2(bflo(uw.y) - acc[2], bfhi(uw.y) - acc[3]);
            *(LAS u32x2*)(VNTs + (16 * vt + fr) * 72 + 16 * ctile + 4 * fq) = w; }
        __syncthreads();
#pragma unroll
        for (int e = 0; e < 4; ++e) { const int t = wave * 4 + e, ctile = t & 3, vt = t >> 2; f32x4 acc = (f32x4){0.f, 0.f, 0.f, 0.f};
            mma_tile<128>(acc, STs + vt * 16 * 136, 136, QGs + ctile * 16 * 136, 136, lane);
            mma_tile<64>(acc, VNTs + vt * 16 * 72, 72, ATs + ctile * 16 * 72, 72, lane);
            *(LAS f32x4*)(Os + (16 * ctile + fr) * 132 + 16 * vt + 4 * fq) = acc; }
#pragma unroll
        for (int e = 0; e < 8; ++e) { const int T = wave * 8 + e, dt = T >> 3, vt = T & 7; accS[e] = accS[e] * gl;
            mma_tile<64>(accS[e], KDTs + dt * 16 * 72, 72, VNTs + vt * 16 * 72, 72, lane); }
        __syncthreads();
        { const int c = tid >> 3, part = tid & 7; float o[16]; float ss = 0.f;
#pragma unroll
          for (int j = 0; j < 4; ++j) { const f32x4 v = *(const LAS f32x4*)(Os + c * 132 + part * 16 + 4 * j); o[4 * j] = v[0]; o[4 * j + 1] = v[1]; o[4 * j + 2] = v[2]; o[4 * j + 3] = v[3];
              ss += (v[0] * v[0] + v[1] * v[1]) + (v[2] * v[2] + v[3] * v[3]); }
          ss += __shfl_xor(ss, 1); ss += __shfl_xor(ss, 2); ss += __shfl_xor(ss, 4);
          const float rstd = 1.0f / sqrtf(ss * (1.0f / 128.0f) + EPS);
          const bf16* zp = P + (size_t)(r0 + c) * GINP + 8192 + hv * 128 + part * 16; float z[16]; { float t8[8]; unpack8(*(const u32x4*)zp, t8);
#pragma unroll
              for (int j = 0; j < 8; ++j) z[j] = t8[j];
              unpack8(*(const u32x4*)(zp + 8), t8);
#pragma unroll
              for (int j = 0; j < 8; ++j) z[8 + j] = t8[j]; }
          float r[16];
#pragma unroll
          for (int j = 0; j < 16; ++j) r[j] = o[j] * rstd * normw[part * 16 + j] * silu_f(z[j]);
          bf16* ap = AO + (size_t)(r0 + c) * RV + hv * 128 + part * 16; u32x4 w;
          w.x = pk2(r[0], r[1]); w.y = pk2(r[2], r[3]); w.z = pk2(r[4], r[5]); w.w = pk2(r[6], r[7]); *(u32x4*)ap = w;
          w.x = pk2(r[8], r[9]); w.y = pk2(r[10], r[11]); w.z = pk2(r[12], r[13]); w.w = pk2(r[14], r[15]); *(u32x4*)(ap + 8) = w; }
    }
#pragma unroll
    for (int e = 0; e < 8; ++e) { const int T = wave * 8 + e, dt = T >> 3, vt = T & 7;
#pragma unroll
        for (int ii = 0; ii < 4; ++ii) gdnp[((size_t)it * 128 + 16 * dt + 4 * fq + ii) * 128 + 16 * vt + fr] = accS[e][ii]; }
    __syncthreads();
}

__device__ __forceinline__ void gdn_sample_item(int it, const bf16* P, const float* AB, const float* convw, const float* alog, const float* dtb, const float* normw,
                                                const float* S0, const float* cst, bf16* AO, float* gdns, LAS unsigned char* lds, int tid, int lane, int wave) {
    const int b = it >> 5, hv = it & 31, hk = hv >> 1;
    const int rbase = MP + b * DSEQ;
    LAS float* qs = (LAS float*)lds;
    LAS float* ks = qs + 1024;
    LAS float* vs = ks + 1024;
    LAS float* os = vs + 1024;
    LAS float* red = os + 1024;
    LAS float* sc = red + 2048;
    if (tid < 8) { const float av = AB[(size_t)(rbase + tid) * 64 + hv], bv = AB[(size_t)(rbase + tid) * 64 + 32 + hv];
        sc[tid] = __expf(-__expf(alog[hv]) * softplus_f(av + dtb[hv])); sc[8 + tid] = sigmoid_f(bv); }
#pragma unroll 1
    for (int i = 0; i < 6; ++i) { const int idx = tid + 512 * i, tok = idx / 384, c = idx % 384, ct = c >> 7, cc = c & 127;
        const int ch = (ct == 0 ? hk * 128 : ct == 1 ? 2048 + hk * 128 : 4096 + hv * 128) + cc; float acc = 0.f;
#pragma unroll
        for (int tap = 0; tap < 4; ++tap) { const int f = tok + tap; const float xv = f < 3 ? cst[((size_t)b * 3 + f) * CONVCH + ch] : bf2f(P[(size_t)(rbase + f - 3) * GINP + ch]);
            acc += xv * convw[tap * CONVCH + ch]; }
        acc = silu_f(acc);
        if (ct == 0) qs[tok * 128 + cc] = acc; else if (ct == 1) ks[tok * 128 + cc] = acc; else vs[tok * 128 + cc] = acc; }
    __syncthreads();
    { const int tok = wave; float q0 = qs[tok * 128 + lane], q1 = qs[tok * 128 + 64 + lane], k0 = ks[tok * 128 + lane], k1 = ks[tok * 128 + 64 + lane];
      const float sq = wave_sum(q0 * q0 + q1 * q1), sk = wave_sum(k0 * k0 + k1 * k1);
      const float rq = (1.0f / sqrtf(sq + EPS)) * 0.08838834764831845f, rk = 1.0f / sqrtf(sk + EPS);
      q0 *= rq; q1 *= rq; k0 *= rk; k1 *= rk;
      const float kq = wave_sum(q0 * k0 + q1 * k1);
      qs[tok * 128 + lane] = q0; qs[tok * 128 + 64 + lane] = q1; ks[tok * 128 + lane] = k0; ks[tok * 128 + 64 + lane] = k1;
      if (lane == 0) sc[16 + tok] = kq; }
    __syncthreads();
    const int v = tid & 127, rq4 = tid >> 7;
    float S[32];
    const float* sp = S0 + ((size_t)it * 128 + rq4 * 32) * 128 + v;
#pragma unroll
    for (int j = 0; j < 32; ++j) S[j] = sp[(size_t)j * 128];
#pragma unroll 1
    for (int tok = 0; tok < 8; ++tok) {
        float pk = 0.f, pq = 0.f;
#pragma unroll
        for (int j = 0; j < 32; ++j) { pk += ks[tok * 128 + rq4 * 32 + j] * S[j]; pq += qs[tok * 128 + rq4 * 32 + j] * S[j]; }
        LAS float* rb = red + (tok & 1) * 1024;
        rb[rq4 * 128 + v] = pk; rb[512 + rq4 * 128 + v] = pq;
        __syncthreads();
        const float kS = (rb[v] + rb[128 + v]) + (rb[256 + v] + rb[384 + v]), qS = (rb[512 + v] + rb[640 + v]) + (rb[768 + v] + rb[896 + v]);
        const float a = sc[tok], bt = sc[8 + tok], kq = sc[16 + tok];
        const float dv = bt * (vs[tok * 128 + v] - a * kS);
        if (rq4 == 0) os[tok * 128 + v] = a * qS + kq * dv;
#pragma unroll
        for (int j = 0; j < 32; ++j) S[j] = a * S[j] + ks[tok * 128 + rq4 * 32 + j] * dv;
    }
    float* dp = gdns + ((size_t)it * 128 + rq4 * 32) * 128 + v;
#pragma unroll
    for (int j = 0; j < 32; ++j) dp[(size_t)j * 128] = S[j];
    __syncthreads();
    { const int tok = wave; const float o0 = os[tok * 128 + lane], o1 = os[tok * 128 + 64 + lane];
      const float ss = wave_sum(o0 * o0 + o1 * o1); const float rstd = 1.0f / sqrtf(ss * (1.0f / 128.0f) + EPS);
      const bf16* zp = P + (size_t)(rbase + tok) * GINP + 8192 + hv * 128; bf16* ap = AO + (size_t)(rbase + tok) * RV + hv * 128;
      ap[lane] = f2bf(o0 * rstd * normw[lane] * silu_f(bf2f(zp[lane]))); ap[64 + lane] = f2bf(o1 * rstd * normw[64 + lane] * silu_f(bf2f(zp[64 + lane]))); }
    __syncthreads();
}

#ifndef ONE_LAUNCH
#define ONE_LAUNCH 1
#endif

template <class Epi>
__device__ __forceinline__ void run_gemm(LAS unsigned char* lds, const bf16* A, const bf16* Bt, int m, int n, int k, const Epi& E) {
    pg8::Gemm g{A, Bt, m, n, k}; pg8::StaticOrder S; S.init(m, n, (int)gridDim.x, (int)blockIdx.x);
    pg8::gemm_phase<Epi, pg8::StaticOrder, true, true>(lds, g, S, E);
}

__global__ void __launch_bounds__(512, 2) fwd_kernel(Args a) {
    extern __shared__ __attribute__((aligned(16))) unsigned char lds_raw[];
    LAS unsigned char* lds = (LAS unsigned char*)lds_raw;
    const int tid = threadIdx.x, lane = tid & 63, wave = __builtin_amdgcn_readfirstlane(tid >> 6);
    const int lo = a.ph_lo, hi = a.ph_hi;
#if ONE_LAUNCH
    volatile LAS unsigned* MISC = (volatile LAS unsigned*)(lds + MISC_OFF);
    if (tid < 4) MISC[tid] = 0u;
    __syncthreads();
    XcdBarrier bar = xcd_barrier_post((unsigned*)(a.ws + WS_CTL), MISC);
#define SEAM(k) do { if ((k) + 1 < hi) xcd_barrier(bar); } while (0)
#else
#define SEAM(k) do { } while (0)
#endif
#define IN(k) (lo <= (k) && (k) < hi)

#define xp (a.in[0])
#define xs (a.in[1])
#define npre (a.in[9])
#define npost (a.in[10])
#define Hb ((bf16*)(a.ws + WS_H))
#define Pb ((bf16*)(a.ws + WS_P))
#define AOb ((bf16*)(a.ws + WS_AO))
#define Yb ((float*)(a.ws + WS_Y))
#define OBb ((float*)(a.ws + WS_OB))
#define MODb ((float*)(a.ws + WS_MOD))
#define ABb ((float*)(a.ws + WS_AB))
#define GLb ((float*)(a.ws + WS_GL))
#define ROTb ((const f32x2*)(a.ws + WS_ROT))

    if (IN(0)) { prep_phase(a, lds, tid, lane, wave); SEAM(0); }
    if (IN(1)) { run_gemm(lds, (const bf16*)(a.ws + WS_CS), (const bf16*)(a.ws + WS_WADA), MODROWS, NMOD, D, pg8::EpiF32{MODb, NMOD, a.in[8]}); SEAM(1); }

    if (IN(2)) { thin_phase<true, false, true>(xp, xs, a.out, Yb, MODb, npost, 0, 0.f, npre + 0 * D, 0 * LMOD + 0 * 6144, Hb, lane, wave); SEAM(2); }
    if (IN(3)) { run_gemm(lds, Hb, (const bf16*)(a.ws + WS_WGU + 0 * SZ_WGU), M, NGU, D, pg8::EpiSwiGLU{Pb, DFF}); SEAM(3); }
    if (IN(4)) { run_gemm(lds, Pb, (const bf16*)(a.ws + WS_WDN + 0 * SZ_WDN), M, D, DFF, pg8::EpiF32{Yb, D, nullptr}); SEAM(4); }
    if (IN(5)) { thin_phase<true, true, true>(xp, xs, a.out, Yb, MODb, npost + 0 * D, 0 * LMOD + 0 * 6144 + 4096, 0.5f, npre + 1 * D, 0 * LMOD + 1 * 6144, Hb, lane, wave); SEAM(5); }
    if (IN(6)) { run_gemm(lds, Hb, (const bf16*)(a.ws + WS_WRI), M, RIN, D, pg8::EpiBf16G{Pb, RIN, nullptr, -1}); SEAM(6); }
    if (IN(7)) {
        for (int it = blockIdx.x; it < 256; it += gridDim.x) ret_prompt_item(it, Pb, ROTb, OBb, a.out + O_RETP, lds, tid, lane, wave);
        for (int it = blockIdx.x; it < DB * 8; it += gridDim.x) ret_sample_item(it, Pb, ROTb, a.in[4], OBb, a.out + O_RETS, lds, tid, lane, wave);
        SEAM(7); }
    if (IN(8)) { ret_norm_phase(OBb, Pb, AOb, lane, wave); SEAM(8); }
    if (IN(9)) { run_gemm(lds, AOb, (const bf16*)(a.ws + WS_WRO), M, D, RV, pg8::EpiF32{Yb, D, nullptr}); SEAM(9); }
    if (IN(10)) { thin_phase<false, true, true>(xp, xs, a.out, Yb, MODb, npost + 1 * D, 0 * LMOD + 1 * 6144 + 4096, 1.0f, npre + 2 * D, 0 * LMOD + 2 * 6144, Hb, lane, wave); SEAM(10); }
    if (IN(11)) { run_gemm(lds, Hb, (const bf16*)(a.ws + WS_WGU + 1 * SZ_WGU), M, NGU, D, pg8::EpiSwiGLU{Pb, DFF}); SEAM(11); }
    if (IN(12)) { run_gemm(lds, Pb, (const bf16*)(a.ws + WS_WDN + 1 * SZ_WDN), M, D, DFF, pg8::EpiF32{Yb, D, nullptr}); SEAM(12); }
    if (IN(13)) { thin_phase<false, true, true>(xp, xs, a.out, Yb, MODb, npost + 2 * D, 0 * LMOD + 2 * 6144 + 4096, 0.5f, npre + 3 * D, 1 * LMOD + 0 * 6144, Hb, lane, wave); SEAM(13); }

    if (IN(14)) { run_gemm(lds, Hb, (const bf16*)(a.ws + WS_WGU + 2 * SZ_WGU), M, NGU, D, pg8::EpiSwiGLU{Pb, DFF}); SEAM(14); }
    if (IN(15)) { run_gemm(lds, Pb, (const bf16*)(a.ws + WS_WDN + 2 * SZ_WDN), M, D, DFF, pg8::EpiF32{Yb, D, nullptr}); SEAM(15); }
    if (IN(16)) { thin_phase<false, true, true>(xp, xs, a.out, Yb, MODb, npost + 3 * D, 1 * LMOD + 0 * 6144 + 4096, 0.5f, npre + 4 * D, 1 * LMOD + 1 * 6144, Hb, lane, wave); SEAM(16); }
    if (IN(17)) { run_gemm(lds, Hb, (const bf16*)(a.ws + WS_WGI), M, GINP, D, pg8::EpiBf16G{Pb, GINP, ABb, 48}); SEAM(17); }
    if (IN(18)) {
        for (int it = blockIdx.x; it < 4096; it += gridDim.x) gdn_f1_item(it, Pb, ABb, a.in[16], a.in[17], a.in[18], a.ws + WS_F1, GLb, lds, tid, lane, wave);
        for (int it = blockIdx.x; it < 4096; it += gridDim.x) gdn_sample_item(it, Pb, ABb, a.in[16], a.in[17], a.in[18], a.in[19], a.in[5], a.in[6], AOb, a.out + O_GDNS, lds, tid, lane, wave);
        { const size_t gt = (size_t)blockIdx.x * 512 + tid, GT = (size_t)gridDim.x * 512;
          for (size_t i = gt; i < (size_t)(NB + DB) * 3 * CONVCH; i += GT) { const int ch = (int)(i % CONVCH), j = (int)((i / CONVCH) % 3), bb = (int)(i / (3 * CONVCH));
              const int row = bb < NB ? bb * SEQ + SEQ - 3 + j : MP + (bb - NB) * DSEQ + DSEQ - 3 + j;
              a.out[O_CONVP + i] = bf2f(Pb[(size_t)row * GINP + ch]); } }
        SEAM(18); }
    if (IN(19)) { for (int it = blockIdx.x; it < 128; it += gridDim.x) gdn_f2_item(it, a.ws + WS_F1, GLb, Pb, a.in[19], AOb, a.out + O_GDNP, lds, tid, lane, wave); SEAM(19); }
    if (IN(20)) { run_gemm(lds, AOb, (const bf16*)(a.ws + WS_WGO), M, D, RV, pg8::EpiF32{Yb, D, nullptr}); SEAM(20); }
    if (IN(21)) { thin_phase<false, true, true>(xp, xs, a.out, Yb, MODb, npost + 4 * D, 1 * LMOD + 1 * 6144 + 4096, 1.0f, npre + 5 * D, 1 * LMOD + 2 * 6144, Hb, lane, wave); SEAM(21); }
    if (IN(22)) { run_gemm(lds, Hb, (const bf16*)(a.ws + WS_WGU + 3 * SZ_WGU), M, NGU, D, pg8::EpiSwiGLU{Pb, DFF}); SEAM(22); }
    if (IN(23)) { run_gemm(lds, Pb, (const bf16*)(a.ws + WS_WDN + 3 * SZ_WDN), M, D, DFF, pg8::EpiF32{Yb, D, nullptr}); SEAM(23); }
    if (IN(24)) { thin_phase<false, true, false>(xp, xs, a.out, Yb, MODb, npost + 5 * D, 1 * LMOD + 2 * 6144 + 4096, 0.5f, npre, 0, Hb, lane, wave); }
#undef IN
#undef SEAM
#undef xp
#undef xs
#undef npre
#undef npost
#undef Hb
#undef Pb
#undef AOb
#undef Yb
#undef OBb
#undef MODb
#undef ABb
#undef GLb
#undef ROTb
}

extern "C" void kernel_launch(void* const* d_in, const int* in_sizes, int n_in, void* d_out, int out_size, void* d_ws, size_t ws_size, hipStream_t stream) {
    static int grid = 0;
    if (grid == 0) {
        if (n_in != 21 || (size_t)out_size != O_END || ws_size < WS_END) { fprintf(stderr, "kernel_launch: unexpected problem: n_in %d out %d ws %zu (need %zu)\n", n_in, out_size, ws_size, (size_t)WS_END); grid = -1; return; }
        int dev = 0, cus = 0, per_cu = 0;
        if (hipGetDevice(&dev) != hipSuccess || hipDeviceGetAttribute(&cus, hipDeviceAttributeMultiprocessorCount, dev) != hipSuccess) { grid = -1; return; }
        if (hipFuncSetAttribute((const void*)fwd_kernel, hipFuncAttributeMaxDynamicSharedMemorySize, LDS_BYTES) != hipSuccess) { fprintf(stderr, "kernel_launch: hipFuncSetAttribute failed\n"); grid = -1; return; }
        if (hipOccupancyMaxActiveBlocksPerMultiprocessor(&per_cu, (const void*)fwd_kernel, 512, LDS_BYTES) != hipSuccess || per_cu < 1) { fprintf(stderr, "kernel_launch: occupancy query says %d blocks per CU\n", per_cu); }
        (void)hipGetLastError();
        grid = cus;
    }
    if (grid < 0) return;
    (void)hipMemsetAsync((char*)d_ws + WS_CTL, 0, CTL_BYTES, stream);
    Args a{};
    for (int i = 0; i < 21; ++i) a.in[i] = (const float*)d_in[i];
    a.out = (float*)d_out; a.ws = (unsigned char*)d_ws;
#if ONE_LAUNCH
    a.ph_lo = 0; a.ph_hi = NPH;
    hipLaunchKernelGGL(fwd_kernel, dim3(grid), dim3(512), LDS_BYTES, stream, a);
#else
    for (int k = 0; k < NPH; ++k) { a.ph_lo = k; a.ph_hi = k + 1; hipLaunchKernelGGL(fwd_kernel, dim3(grid), dim3(512), LDS_BYTES, stream, a); }
#endif
    const hipError_t le = hipPeekAtLastError();
    if (le != hipSuccess) fprintf(stderr, "kernel_launch: launch failed: %s\n", hipGetErrorName(le));
}
```

```cpp
#include <hip/hip_runtime.h>
#include <cstdio>
#include <cstdint>
#define ONE_LAUNCH 1
#define PROBE_MASK 0x0u
namespace pg8 {
#define PG8_LAS __attribute__((address_space(3)))
typedef unsigned short bf16_t;
typedef short bf16x8 __attribute__((ext_vector_type(8)));
typedef float f32x4 __attribute__((ext_vector_type(4)));
typedef unsigned u32x4 __attribute__((ext_vector_type(4)));
constexpr int BM = 256, BK = 64, HALF = 128, HTB = HALF * BK * 2  , STAGE_BYTES = 8 * HTB, NXCD = 8, WGM = 8;

__host__ __device__ __forceinline__ int lds_byte(int r, int c) { const int st = (r >> 4) * 2 + (c >> 5), rr = r & 15, cc = c & 31, ob = rr * 64 + cc * 2; return st * 1024 + (ob ^ (((ob >> 9) & 1) << 5)); }
__host__ __device__ __forceinline__ void stage_rc(int b, int& R, int& C) { const int st = b / 1024, sb = b % 1024, swz = sb ^ (((sb >> 9) & 1) << 5); R = (st >> 1) * 16 + swz / 64; C = (st & 1) * 32 + (swz % 64) / 2; }
__host__ __device__ __forceinline__ int perm32(int rho) { const int n = rho >> 4, i = rho & 15; return 8 * (i >> 2) + 4 * n + (i & 3); }

struct Unit { int pm, pn, k0, nt, ks; };
struct Gemm { const bf16_t* A; const bf16_t* Bt; int M, N, K; };

struct StaticOrder {
    int nM, nN, nwg, G, c, ntf;
    __host__ __device__ void init(int M, int N, int K, int G_, int c_) { nM = M / BM; nN = N / BM; nwg = nM * nN; G = G_; c = c_; ntf = K / BK; }
    __host__ __device__ bool next(int i, Unit& u) const {
        const long L = (long)i * G + c; if (L >= nwg) return false;
        int wgid = (int)L; { const int q = nwg / NXCD, r = nwg % NXCD, xcd = wgid % NXCD, off = wgid / NXCD; wgid = (xcd < r ? xcd * (q + 1) : r * (q + 1) + (xcd - r) * q) + off; }
        const int nig = WGM * nN, gid = wgid / nig, fm = gid * WGM, gsz = (nM - fm) < WGM ? (nM - fm) : WGM;
        u.pm = fm + ((wgid % nig) % gsz); u.pn = (wgid % nig) / gsz; u.k0 = 0; u.nt = ntf; u.ks = -1; return true;
    }
    __device__ __forceinline__ void a_ready(const Unit&) const {}
    __device__ __forceinline__ void done(const Unit&) const {}
};
typedef __bf16 bf16x2_t __attribute__((ext_vector_type(2)));
typedef float f32x2_t __attribute__((ext_vector_type(2)));
__device__ __forceinline__ unsigned cvt_pk_bf16(float lo, float hi) { const f32x2_t v = {lo, hi}; const bf16x2_t b = __builtin_convertvector(v, bf16x2_t); return __builtin_bit_cast(unsigned, b); }
typedef unsigned u32x2 __attribute__((ext_vector_type(2)));

struct EpiF32 {
    static constexpr bool PERM = false, AFTER_DRAIN = false;
    float* C; int ldc; const float* bias;
    __device__ __forceinline__ void operator()(const f32x4 (&acc)[2][2][4][2], const Unit& u, int wr, int wc, int fr, int fq) const {
        const int row0 = u.pm * BM + wr * 64 + fr, col0 = u.pn * BM + wc * 32 + 4 * fq;
        f32x4 bv[2][2];
#pragma unroll
        for (int bj = 0; bj < 2; ++bj)
#pragma unroll
            for (int n = 0; n < 2; ++n) bv[bj][n] = bias ? *(const f32x4*)(bias + col0 + bj * HALF + n * 16) : (f32x4){0.f, 0.f, 0.f, 0.f};
#pragma unroll
        for (int ai = 0; ai < 2; ++ai)
#pragma unroll
            for (int m = 0; m < 4; ++m) { float* rowp = C + (size_t)(row0 + ai * HALF + m * 16) * ldc + col0;
#pragma unroll
                for (int bj = 0; bj < 2; ++bj)
#pragma unroll
                    for (int n = 0; n < 2; ++n) *(f32x4*)(rowp + bj * HALF + n * 16) = acc[ai][bj][m][n] + bv[bj][n]; }
    }
};
struct EpiBf16G {
    static constexpr bool PERM = true, AFTER_DRAIN = false;
    bf16_t* O; int ldc; float* ab; int abtile;
    __device__ __forceinline__ void operator()(const f32x4 (&acc)[2][2][4][2], const Unit& u, int wr, int wc, int fr, int fq) const {
        const int row0 = u.pm * BM + wr * 64 + fr; const int col0 = u.pn * BM + wc * 32 + 8 * fq;
#pragma unroll
        for (int ai = 0; ai < 2; ++ai)
#pragma unroll
            for (int m = 0; m < 4; ++m) { bf16_t* rowp = O + (size_t)(row0 + ai * HALF + m * 16) * ldc + col0;
#pragma unroll
                for (int bj = 0; bj < 2; ++bj) { const f32x4 v0 = acc[ai][bj][m][0], v1 = acc[ai][bj][m][1];
                    u32x4 w; w.x = cvt_pk_bf16(v0[0], v0[1]); w.y = cvt_pk_bf16(v0[2], v0[3]); w.z = cvt_pk_bf16(v1[0], v1[1]); w.w = cvt_pk_bf16(v1[2], v1[3]);
                    *(u32x4*)(rowp + bj * HALF) = w; } }
        if (ab != nullptr && u.pn == abtile && wc < 2) {
#pragma unroll
            for (int ai = 0; ai < 2; ++ai)
#pragma unroll
                for (int m = 0; m < 4; ++m) { float* rp = ab + (size_t)(row0 + ai * HALF + m * 16) * 64 + wc * 32 + 8 * fq;
                    *(f32x4*)(rp) = acc[ai][0][m][0]; *(f32x4*)(rp + 4) = acc[ai][0][m][1]; }
        }
    }
};
struct EpiSwiGLU {
    static constexpr bool PERM = false, AFTER_DRAIN = false;
    bf16_t* O; int ldc;
    __device__ __forceinline__ void operator()(const f32x4 (&acc)[2][2][4][2], const Unit& u, int wr, int wc, int fr, int fq) const {
        const int row0 = u.pm * BM + wr * 64 + fr; const int col0 = u.pn * HALF + wc * 32 + 8 * fq;
#pragma unroll
        for (int ai = 0; ai < 2; ++ai)
#pragma unroll
            for (int m = 0; m < 4; ++m) { bf16_t* rowp = O + (size_t)(row0 + ai * HALF + m * 16) * ldc + col0; float r[8];
#pragma unroll
                for (int bj = 0; bj < 2; ++bj) { const f32x4 g = acc[ai][bj][m][0], up = acc[ai][bj][m][1];
#pragma unroll
                    for (int j = 0; j < 4; ++j) r[4 * bj + j] = g[j] * __builtin_amdgcn_rcpf(1.0f + __expf(-g[j])) * up[j]; }
                u32x4 w; w.x = cvt_pk_bf16(r[0], r[1]); w.y = cvt_pk_bf16(r[2], r[3]); w.z = cvt_pk_bf16(r[4], r[5]); w.w = cvt_pk_bf16(r[6], r[7]);
                *(u32x4*)rowp = w; }
    }
};
struct TailSplitOrder {
    StaticOrder S0; int q, P;
    __host__ __device__ void init(int N, int K, int G, int c) { S0.init(32 * BM, N, K, G, c); q = (c % NXCD) * (G / NXCD) + c / NXCD; P = K / 128; }
    __host__ __device__ bool next(int i, Unit& u) const {
        if (i == 0) return S0.next(0, u);
        if (i == 1) { const int x = q >> 5, l = q & 31, j = l & 7, t = l >> 3; u.pm = 32 + 2 * (x >> 2) + (t >> 1); u.pn = 2 * (x & 3) + (t & 1); const int p0 = (P * j) >> 3, p1 = (P * (j + 1)) >> 3; u.k0 = p0 * 128; u.nt = (p1 - p0) * 2; u.ks = j; return true; }
        return false;
    }
    __device__ __forceinline__ void a_ready(const Unit&) const {}
    __device__ __forceinline__ void done(const Unit&) const {}
};
struct EpiY {
    static constexpr bool PERM = true, AFTER_DRAIN = false;
    bf16_t* Y; int ldc; bf16_t* S; size_t slab_stride;
    __device__ __forceinline__ void operator()(const f32x4 (&acc)[2][2][4][2], const Unit& u, int wr, int wc, int fr, int fq) const {
        const int col0 = u.pn * BM + wc * 32 + 8 * fq; const bool tail = u.ks >= 0;
        bf16_t* base = tail ? S + (size_t)u.ks * slab_stride : Y;
        const int row0 = (tail ? u.pm - 32 : u.pm) * BM + wr * 64 + fr;
#pragma unroll
        for (int ai = 0; ai < 2; ++ai)
#pragma unroll
            for (int m = 0; m < 4; ++m) { bf16_t* rowp = base + (size_t)(row0 + ai * HALF + m * 16) * ldc + col0;
#pragma unroll
                for (int bj = 0; bj < 2; ++bj) { const f32x4 v0 = acc[ai][bj][m][0], v1 = acc[ai][bj][m][1];
                    u32x4 w; w.x = cvt_pk_bf16(v0[0], v0[1]); w.y = cvt_pk_bf16(v0[2], v0[3]); w.z = cvt_pk_bf16(v1[0], v1[1]); w.w = cvt_pk_bf16(v1[2], v1[3]);
                    *(u32x4*)(rowp + bj * HALF) = w; } }
    }
};
template <class Epi, class Sched, bool ALIGN_EPI = false, bool SP2 = false>
__device__ __forceinline__ void gemm_phase(PG8_LAS unsigned char* lds, const Gemm g, const Sched& S, const Epi& E) {
    const int tid = threadIdx.x, wid = __builtin_amdgcn_readfirstlane(tid >> 6), lane = tid & 63, wr = wid >> 2, wc = wid & 3, fr = lane & 15, fq = lane >> 4;
    const int K = g.K;
    unsigned voffA[2], voffB[2];
#pragma unroll
    for (int i = 0; i < 2; ++i) { int R, C; stage_rc(tid * 16 + i * 8192, R, C); const int Rb = Epi::PERM ? ((R & ~31) + perm32(R & 31)) : R;
        voffA[i] = (unsigned)(R * K + C) * 2u; voffB[i] = (unsigned)(Rb * K + C) * 2u; }
    const size_t kstep = (size_t)(BK * 2);
    const size_t hstep = (size_t)HALF * K * 2;
    const size_t tstep = 2 * hstep;
    const unsigned ldsw = (unsigned)wid * 1024u;
    const int aoff = lds_byte(wr * 64 + fr, fq * 8), boff = lds_byte(wc * 32 + fr, fq * 8);
#define PG8_SA(b, h) (((b) * 2 + (h)) * HTB)
#define PG8_SB(b, h) ((4 + (b) * 2 + (h)) * HTB)
#define PG8_STAGE(bufoff, gbase, voff) do { _Pragma("unroll") for (int _i = 0; _i < 2; ++_i) \
        __builtin_amdgcn_global_load_lds((const unsigned*)((const char*)(gbase) + (voff)[_i]), (PG8_LAS unsigned*)(lds + (bufoff) + ldsw + _i * 8192), 16, 0, 0); } while (0)
#define PG8_LDA(dst, b, h) do { _Pragma("unroll") for (int m = 0; m < 4; ++m) _Pragma("unroll") for (int k = 0; k < 2; ++k) dst[m][k] = *(const PG8_LAS bf16x8*)(lds + PG8_SA(b, h) + aoff + m * 2048 + k * 1024); } while (0)
#define PG8_LDB(dst, b, h) do { _Pragma("unroll") for (int n = 0; n < 2; ++n) _Pragma("unroll") for (int k = 0; k < 2; ++k) dst[n][k] = *(const PG8_LAS bf16x8*)(lds + PG8_SB(b, h) + boff + n * 2048 + k * 1024); } while (0)
#define PG8_MMA(ai, bj, At, Bt) do { __builtin_amdgcn_s_setprio(1); _Pragma("unroll") for (int m = 0; m < 4; ++m) _Pragma("unroll") for (int n = 0; n < 2; ++n) _Pragma("unroll") for (int k = 0; k < 2; ++k) \
        acc[ai][bj][m][n] = __builtin_amdgcn_mfma_f32_16x16x32_bf16(Bt[n][k], At[m][k], acc[ai][bj][m][n], 0, 0, 0); __builtin_amdgcn_s_setprio(0); } while (0)
#define PG8_WAIT_V(n) asm volatile("s_waitcnt vmcnt(" #n ")" ::: "memory")
#define PG8_WAIT_L(n) asm volatile("s_waitcnt lgkmcnt(" #n ")" ::: "memory")
#define PG8_BAR __builtin_amdgcn_s_barrier()
#define PG8_SCHED __builtin_amdgcn_sched_barrier(0)
    Unit cur, nxt; int ui = 0;
    if (!S.next(0, cur)) return;
    f32x4 acc[2][2][4][2];
#pragma unroll
    for (int a = 0; a < 2; ++a)
#pragma unroll
        for (int b = 0; b < 2; ++b)
#pragma unroll
            for (int m = 0; m < 4; ++m)
#pragma unroll
                for (int n = 0; n < 2; ++n) acc[a][b][m][n] = (f32x4){0.f, 0.f, 0.f, 0.f};
    bf16x8 At[4][2], B0[2][2], B1[2][2];
    const char* cA = (const char*)g.A + (size_t)cur.pm * tstep + (size_t)cur.k0 * 2; const char* cB = (const char*)g.Bt + (size_t)cur.pn * tstep + (size_t)cur.k0 * 2;
    S.a_ready(cur);
    if constexpr (SP2) {
        PG8_STAGE(PG8_SB(0, 0), cB, voffB); PG8_STAGE(PG8_SB(0, 1), cB + hstep, voffB); PG8_STAGE(PG8_SA(0, 0), cA, voffA); PG8_STAGE(PG8_SA(0, 1), cA + hstep, voffA);
        if (wr == 1) PG8_BAR;
        PG8_WAIT_V(2); PG8_BAR;
        PG8_STAGE(PG8_SB(1, 0), cB + kstep, voffB); PG8_STAGE(PG8_SA(1, 0), cA + kstep, voffA); PG8_STAGE(PG8_SB(1, 1), cB + hstep + kstep, voffB);
        PG8_WAIT_V(6); PG8_BAR;
    } else {
        PG8_STAGE(PG8_SB(0, 0), cB, voffB); PG8_STAGE(PG8_SA(0, 0), cA, voffA); PG8_STAGE(PG8_SB(0, 1), cB + hstep, voffB); PG8_STAGE(PG8_SA(0, 1), cA + hstep, voffA);
        if (wr == 1) PG8_BAR;
        PG8_WAIT_V(4); PG8_BAR;
        PG8_STAGE(PG8_SB(1, 0), cB + kstep, voffB); PG8_STAGE(PG8_SA(1, 0), cA + kstep, voffA); PG8_STAGE(PG8_SB(1, 1), cB + hstep + kstep, voffB);
        PG8_WAIT_V(6); PG8_BAR;
    }
    for (;;) {
        const bool has_next = S.next(ui + 1, nxt);
        const char* nA = has_next ? (const char*)g.A + (size_t)nxt.pm * tstep + (size_t)nxt.k0 * 2 : cA; const char* nB = has_next ? (const char*)g.Bt + (size_t)nxt.pn * tstep + (size_t)nxt.k0 * 2 : cB;
        const int nt = cur.nt;
        for (int t = 0; t < nt; t += 2) {
            const bool last = (t == nt - 2);
            const char* a1 = cA + (size_t)(t + 1) * kstep;
            const char* a2 = last ? nA : cA + (size_t)(t + 2) * kstep; const char* b2 = last ? nB : cB + (size_t)(t + 2) * kstep;
            const char* a3 = a2 + kstep; const char* b3 = b2 + kstep;
            if (last && has_next) S.a_ready(nxt);
            if constexpr (SP2) {
            PG8_LDB(B0, 0, 0); PG8_LDB(B1, 0, 1); PG8_SCHED; PG8_LDA(At, 0, 0); PG8_STAGE(PG8_SA(1, 1), a1 + hstep, voffA);
            PG8_WAIT_V(8); PG8_WAIT_L(0); PG8_BAR; PG8_MMA(0, 0, At, B0); PG8_MMA(0, 1, At, B1); PG8_BAR; PG8_SCHED;
            PG8_LDA(At, 0, 1); PG8_STAGE(PG8_SB(0, 0), b2, voffB); PG8_STAGE(PG8_SB(0, 1), b2 + hstep, voffB); PG8_STAGE(PG8_SA(0, 0), a2, voffA);
            PG8_WAIT_V(8); PG8_WAIT_L(0); PG8_BAR; PG8_MMA(1, 0, At, B0); PG8_MMA(1, 1, At, B1); PG8_BAR; PG8_SCHED;
            PG8_LDB(B0, 1, 0); PG8_LDB(B1, 1, 1); PG8_SCHED; PG8_LDA(At, 1, 0); PG8_STAGE(PG8_SA(0, 1), a2 + hstep, voffA);
            PG8_WAIT_V(8); PG8_WAIT_L(0); PG8_BAR; PG8_MMA(0, 0, At, B0); PG8_MMA(0, 1, At, B1); PG8_BAR; PG8_SCHED;
            PG8_LDA(At, 1, 1); PG8_STAGE(PG8_SB(1, 0), b3, voffB); PG8_STAGE(PG8_SB(1, 1), b3 + hstep, voffB); PG8_STAGE(PG8_SA(1, 0), a3, voffA);
            PG8_WAIT_V(8); PG8_WAIT_L(0); PG8_BAR; PG8_MMA(1, 0, At, B0); PG8_MMA(1, 1, At, B1); PG8_BAR; PG8_SCHED;
            } else {
            PG8_LDB(B0, 0, 0); PG8_SCHED; PG8_LDA(At, 0, 0); PG8_STAGE(PG8_SA(1, 1), a1 + hstep, voffA);
            PG8_WAIT_L(8); PG8_BAR; PG8_WAIT_L(0); PG8_MMA(0, 0, At, B0); PG8_BAR; PG8_SCHED;
            PG8_LDB(B1, 0, 1); PG8_STAGE(PG8_SB(0, 0), b2, voffB);
            PG8_BAR; PG8_WAIT_L(0); PG8_MMA(0, 1, At, B1); PG8_BAR;
            PG8_LDA(At, 0, 1); PG8_STAGE(PG8_SA(0, 0), a2, voffA);
            PG8_BAR; PG8_WAIT_L(0); PG8_MMA(1, 0, At, B0); PG8_BAR; PG8_SCHED;
            PG8_STAGE(PG8_SB(0, 1), b2 + hstep, voffB);
            PG8_WAIT_V(6); PG8_BAR; PG8_MMA(1, 1, At, B1); PG8_BAR;
            PG8_LDB(B0, 1, 0); PG8_SCHED; PG8_LDA(At, 1, 0); PG8_STAGE(PG8_SA(0, 1), a2 + hstep, voffA);
            PG8_WAIT_L(8); PG8_BAR; PG8_WAIT_L(0); PG8_MMA(0, 0, At, B0); PG8_BAR; PG8_SCHED;
            PG8_LDB(B1, 1, 1); PG8_STAGE(PG8_SB(1, 0), b3, voffB);
            PG8_BAR; PG8_WAIT_L(0); PG8_MMA(0, 1, At, B1); PG8_BAR;
            PG8_LDA(At, 1, 1); PG8_STAGE(PG8_SA(1, 0), a3, voffA);
            PG8_BAR; PG8_WAIT_L(0); PG8_MMA(1, 0, At, B0); PG8_BAR; PG8_SCHED;
            PG8_STAGE(PG8_SB(1, 1), b3 + hstep, voffB);
            PG8_WAIT_V(6); PG8_BAR; PG8_MMA(1, 1, At, B1); PG8_BAR;
            }
        }
        if constexpr (ALIGN_EPI) { if (wr == 0) PG8_BAR; }
        if constexpr (!Epi::AFTER_DRAIN) { E(acc, cur, wr, wc, fr, fq); S.done(cur); }
        if (!has_next) break;
#pragma unroll
        for (int a = 0; a < 2; ++a)
#pragma unroll
            for (int b = 0; b < 2; ++b)
#pragma unroll
                for (int m = 0; m < 4; ++m)
#pragma unroll
                    for (int n = 0; n < 2; ++n) acc[a][b][m][n] = (f32x4){0.f, 0.f, 0.f, 0.f};
        cur = nxt; cA = nA; cB = nB; ++ui;
        if constexpr (ALIGN_EPI) { if (wr == 1) PG8_BAR; }
    }
    PG8_WAIT_V(0);
    if constexpr (!ALIGN_EPI) { if (wr == 0) PG8_BAR; }
    PG8_BAR;
    if constexpr (Epi::AFTER_DRAIN) { E.fused(acc, cur, wr, wc, fr, fq, lds, wid, lane); S.done(cur); }
#undef PG8_SA
#undef PG8_SB
#undef PG8_STAGE
#undef PG8_LDA
#undef PG8_LDB
#undef PG8_MMA
#undef PG8_WAIT_V
#undef PG8_WAIT_L
#undef PG8_BAR
#undef PG8_SCHED
}
}
#define XB_TMO      128
#define XB_XCNT(j)  (256  + 64 * (j))
#define XB_XSUB(j)  (1280 + 64 * (j))
#define XB_XGEN(j)  (2304 + 64 * (j))
#define XB_TOP      3328
#define XB_TOPGEN   3392
#define XCD_BAR_WORDS 3456
#define XB_SPIN_CAP (1u << 18)
#define LAS __attribute__((address_space(3)))

__device__ __forceinline__ unsigned xb_ld(unsigned* p)              { return __hip_atomic_load(p, __ATOMIC_RELAXED, __HIP_MEMORY_SCOPE_AGENT); }
__device__ __forceinline__ unsigned xb_add(unsigned* p, unsigned v) { return __hip_atomic_fetch_add(p, v, __ATOMIC_RELAXED, __HIP_MEMORY_SCOPE_AGENT); }
__device__ __forceinline__ unsigned xb_xcc_id() { return (unsigned)__builtin_amdgcn_s_getreg((3 << 11) | 20) & 0xFu; }
#define XB_SPIN(cond, bar) do { unsigned _sp = 0; while (cond) { __builtin_amdgcn_s_sleep(1); \
    if ((++_sp & 255u) == 0u) { if (xb_ld(&(bar)[XB_TMO])) break; if (_sp > XB_SPIN_CAP) { atomicAdd(&(bar)[XB_TMO], 1u); break; } } } } while (0)

struct XcdBarrier {
    unsigned* bar; unsigned x;
    volatile LAS unsigned* st;
};

__device__ __forceinline__ XcdBarrier xcd_barrier_post(unsigned* bar, volatile LAS unsigned* st) {
    XcdBarrier b; b.bar = bar; b.x = xb_xcc_id(); b.st = st;
    if (threadIdx.x == 0) (void)xb_add(&bar[XB_XCNT(b.x)], 1u);
    return b;
}
__device__ __forceinline__ void xcd_barrier_complete(unsigned* bar, unsigned x, unsigned& nloc, unsigned& nx) {
    const unsigned G = gridDim.x * gridDim.y * gridDim.z;
    unsigned sum, cnt, mine, sp = 0u;
    for (;;) {
        sum = 0u; cnt = 0u; mine = 0u;
#pragma unroll
        for (unsigned j = 0; j < 16; ++j) { const unsigned c = xb_ld(&bar[XB_XCNT(j)]); sum += c; cnt += (c > 0u) ? 1u : 0u; mine = (j == x) ? c : mine; }
        if (sum == G) break;
        __builtin_amdgcn_s_sleep(1);
        if ((++sp & 255u) == 0u) { if (xb_ld(&bar[XB_TMO])) break; if (sp > XB_SPIN_CAP) { atomicAdd(&bar[XB_TMO], 1u); break; } }
    }
    nloc = mine > 0u ? mine : 1u; nx = cnt > 0u ? cnt : 1u;
}

__device__ __forceinline__ void xcd_barrier(const XcdBarrier& b) {
    asm volatile("s_waitcnt vmcnt(0)" ::: "memory");
    __syncthreads();
    if (threadIdx.x == 0) {
        unsigned* bar = b.bar;
        __builtin_amdgcn_s_waitcnt(0);
        unsigned nloc = b.st[0], nx = b.st[1];
        if (nloc == 0u) { xcd_barrier_complete(bar, b.x, nloc, nx); b.st[0] = nloc; b.st[1] = nx; }
        const unsigned old = xb_add(&bar[XB_XSUB(b.x)], 1u);
        const unsigned gen = old / nloc;
        if (old + 1u == (gen + 1u) * nloc) {
            __builtin_amdgcn_fence(__ATOMIC_RELEASE, "agent");
            asm volatile("s_waitcnt vmcnt(0)" ::: "memory");
            const unsigned og = xb_add(&bar[XB_TOP], 1u);
            const unsigned tg = og / nx;
            if (og + 1u == (tg + 1u) * nx) xb_add(&bar[XB_TOPGEN], 1u);
            else XB_SPIN(xb_ld(&bar[XB_TOPGEN]) == tg, bar);
            __builtin_amdgcn_fence(__ATOMIC_ACQUIRE, "agent");
            xb_add(&bar[XB_XGEN(b.x)], 1u);
            asm volatile("s_waitcnt vmcnt(0)" ::: "memory");
        } else {
            XB_SPIN(xb_ld(&bar[XB_XGEN(b.x)]) == gen, bar);
            __builtin_amdgcn_fence(__ATOMIC_ACQUIRE, "agent");
            asm volatile("s_waitcnt vmcnt(0)" ::: "memory");
        }
    }
    __syncthreads();
}


typedef unsigned short bf16;
typedef short bf16x8 __attribute__((ext_vector_type(8)));
typedef float f32x4 __attribute__((ext_vector_type(4)));
typedef float f32x2 __attribute__((ext_vector_type(2)));
typedef unsigned u32x4 __attribute__((ext_vector_type(4)));
typedef unsigned u32x2 __attribute__((ext_vector_type(2)));

constexpr int D = 2048, MP = 8192, MS = 1024, M = MP + MS, DFF = 5632, NGU = 2 * DFF;
constexpr int SEQ = 2048, NB = 4, DB = 128, DSEQ = 8, PAST = 16384;
constexpr int RIN = 12288, RV = 4096;
constexpr int GIN = 12352, GINP = 12544;
constexpr int NMOD = 36864, LMOD = 18432, MODROWS = 256, NMB = 132;
constexpr int CONVCH = 8192;
constexpr float EPS = 1e-6f;
constexpr int NPH = 25;

constexpr size_t O_Y = 0, O_RETP = (size_t)M * D, O_RETS = O_RETP + (size_t)NB * 8 * 256 * 512, O_GDNP = O_RETS + (size_t)DB * 8 * 256 * 512,
                 O_GDNS = O_GDNP + (size_t)NB * 32 * 128 * 128, O_CONVP = O_GDNS + (size_t)DB * 32 * 128 * 128, O_CONVS = O_CONVP + (size_t)NB * 3 * CONVCH,
                 O_END = O_CONVS + (size_t)DB * 3 * CONVCH;

constexpr size_t MiB = 1u << 20;
constexpr size_t al(size_t x) { return (x + MiB - 1) / MiB * MiB; }
constexpr size_t WS_CTL = 0, CTL_BYTES = MiB;
constexpr size_t WS_WADA = WS_CTL + CTL_BYTES;
constexpr size_t WS_WGU = WS_WADA + al((size_t)NMOD * D * 2);
constexpr size_t SZ_WGU = (size_t)NGU * D * 2;
constexpr size_t WS_WDN = WS_WGU + al(4 * SZ_WGU);
constexpr size_t SZ_WDN = (size_t)D * DFF * 2;
constexpr size_t WS_WRI = WS_WDN + al(4 * SZ_WDN);
constexpr size_t WS_WRO = WS_WRI + al((size_t)RIN * D * 2);
constexpr size_t WS_WGI = WS_WRO + al((size_t)D * RV * 2);
constexpr size_t WS_WGO = WS_WGI + al((size_t)GINP * D * 2);
constexpr size_t WS_CS = WS_WGO + al((size_t)D * RV * 2);
constexpr size_t WS_MOD = WS_CS + al((size_t)MODROWS * D * 2);
constexpr size_t WS_ROT = WS_MOD + al((size_t)MODROWS * NMOD * 4);
constexpr size_t WS_H = WS_ROT + al((size_t)2056 * 128 * 8);
constexpr size_t WS_P = WS_H + al((size_t)M * D * 2);
constexpr size_t WS_Y = WS_P + al((size_t)M * GINP * 2);
constexpr size_t WS_XB = WS_Y + al((size_t)M * D * 4);
constexpr size_t WS_YS = WS_XB + al((size_t)M * D * 2);
constexpr size_t WS_OB = WS_YS + al((size_t)8 * MS * D * 4);
constexpr size_t WS_AO = WS_OB + al((size_t)M * RV * 4);
constexpr size_t WS_AB = WS_AO + al((size_t)M * RV * 2);
constexpr size_t WS_GL = WS_AB + al((size_t)M * 64 * 4);
constexpr size_t WS_F1 = WS_GL + MiB;
constexpr size_t F1_ITEM = 73728, F1_QG = 0, F1_W = 16384, F1_UT = 32768, F1_KDT = 49152, F1_ATT = 65536;
constexpr size_t WS_END = WS_F1 + al(4096 * F1_ITEM);

constexpr int LDS_BYTES = 160 * 1024;
constexpr int MISC_OFF = LDS_BYTES - 256;

__device__ __forceinline__ unsigned pk2(float lo, float hi) { return pg8::cvt_pk_bf16(lo, hi); }
__device__ __forceinline__ bf16 f2bf(float f) { return (bf16)(pk2(f, 0.f) & 0xffffu); }
__device__ __forceinline__ float bflo(unsigned w) { return __uint_as_float(w << 16); }
__device__ __forceinline__ float bfhi(unsigned w) { return __uint_as_float(w & 0xffff0000u); }
__device__ __forceinline__ float bf2f(bf16 b) { return __uint_as_float(((unsigned)b) << 16); }
__device__ __forceinline__ void unpack8(const u32x4 w, float (&f)[8]) { f[0] = bflo(w.x); f[1] = bfhi(w.x); f[2] = bflo(w.y); f[3] = bfhi(w.y); f[4] = bflo(w.z); f[5] = bfhi(w.z); f[6] = bflo(w.w); f[7] = bfhi(w.w); }
__device__ __forceinline__ u32x4 pack8(const float (&f)[8]) { u32x4 w; w.x = pk2(f[0], f[1]); w.y = pk2(f[2], f[3]); w.z = pk2(f[4], f[5]); w.w = pk2(f[6], f[7]); return w; }
#define LDS_BARRIER() do { asm volatile("s_waitcnt lgkmcnt(0)" ::: "memory"); __builtin_amdgcn_s_barrier(); asm volatile("" ::: "memory"); } while (0)
__device__ __forceinline__ float wave_sum(float v) {
#pragma unroll
    for (int o = 1; o < 64; o <<= 1) v += __shfl_xor(v, o);
    return v;
}
__device__ __forceinline__ float silu_f(float x) { return x / (1.0f + __expf(-x)); }
__device__ __forceinline__ float silu_fast(float x) { return x * __builtin_amdgcn_rcpf(1.0f + __expf(-x)); }
__device__ __forceinline__ float sigmoid_f(float x) { return 1.0f / (1.0f + __expf(-x)); }
__device__ __forceinline__ float softplus_f(float x) { return fmaxf(x, 0.f) + log1pf(__expf(-fabsf(x))); }

template <int K>
__device__ __forceinline__ void mma_tile(f32x4& acc, const LAS bf16* X, int ldx, const LAS bf16* Y, int ldy, int lane) {
    const int r = lane & 15, kq = lane >> 4;
    const LAS bf16* xp = X + r * ldx + kq * 8;
    const LAS bf16* yp = Y + r * ldy + kq * 8;
#pragma unroll
    for (int k = 0; k < K; k += 32) {
        const bf16x8 a = *(const LAS bf16x8*)(xp + k);
        const bf16x8 b = *(const LAS bf16x8*)(yp + k);
        acc = __builtin_amdgcn_mfma_f32_16x16x32_bf16(a, b, acc, 0, 0, 0);
    }
}

typedef short s16x4 __attribute__((ext_vector_type(4)));
__device__ __forceinline__ bf16x8 frag_tr(const LAS bf16* Mk, int ld, int lane) {
    const int g = lane >> 4, t = lane & 15, q = t >> 2, p = t & 3;
    const LAS bf16* a = Mk + (8 * g + q) * ld + 4 * p;
    const s16x4 lo = __builtin_amdgcn_ds_read_tr16_b64_v4i16((LAS s16x4*)a);
    const s16x4 hi = __builtin_amdgcn_ds_read_tr16_b64_v4i16((LAS s16x4*)(a + 4 * ld));
    return (bf16x8){lo[0], lo[1], lo[2], lo[3], hi[0], hi[1], hi[2], hi[3]};
}
__device__ __forceinline__ bf16x8 frag_n(const LAS bf16* T, int ld, int k0, int lane) { return *(const LAS bf16x8*)(T + (lane & 15) * ld + (lane >> 4) * 8 + k0); }
#define MFMA16(a, b, c) __builtin_amdgcn_mfma_f32_16x16x32_bf16((a), (b), (c), 0, 0, 0)
template <int K, bool XT, bool YT>
__device__ __forceinline__ void mma_tile2(f32x4& acc, const LAS bf16* X, int ldx, const LAS bf16* Y, int ldy, int lane) {
    const int r = lane & 15, kq = lane >> 4;
#pragma unroll
    for (int k = 0; k < K; k += 32) {
        const bf16x8 a = XT ? frag_tr(X + k * ldx, ldx, lane) : *(const LAS bf16x8*)(X + r * ldx + kq * 8 + k);
        const bf16x8 b = YT ? frag_tr(Y + k * ldy, ldy, lane) : *(const LAS bf16x8*)(Y + r * ldy + kq * 8 + k);
        acc = __builtin_amdgcn_mfma_f32_16x16x32_bf16(a, b, acc, 0, 0, 0);
    }
}

__device__ __forceinline__ void sincos_d(double x, double& s, double& c) {
    const double k = rint(x * 0.63661977236758134308);
    double r = fma(-k, 1.57079632679489655800e+00, x);
    r = fma(-k, 6.12323399573676603587e-17, r);
    const double r2 = r * r;
    double ps = -1.0 / 1307674368000.0;
    ps = fma(ps, r2, 1.0 / 6227020800.0); ps = fma(ps, r2, -1.0 / 39916800.0); ps = fma(ps, r2, 1.0 / 362880.0); ps = fma(ps, r2, -1.0 / 5040.0);
    ps = fma(ps, r2, 1.0 / 120.0); ps = fma(ps, r2, -1.0 / 6.0); ps = fma(ps * r2, r, r);
    double pc = 1.0 / 20922789888000.0;
    pc = fma(pc, r2, -1.0 / 87178291200.0); pc = fma(pc, r2, 1.0 / 479001600.0); pc = fma(pc, r2, -1.0 / 3628800.0); pc = fma(pc, r2, 1.0 / 40320.0);
    pc = fma(pc, r2, -1.0 / 720.0); pc = fma(pc, r2, 1.0 / 24.0); pc = fma(pc, r2, -0.5); pc = fma(pc, r2, 1.0);
    const int q = ((int)k) & 3;
    s = (q == 0) ? ps : (q == 1) ? pc : (q == 2) ? -ps : -pc;
    c = (q == 0) ? pc : (q == 1) ? -ps : (q == 2) ? -pc : ps;
}

struct Args { const float* in[21]; float* out; unsigned char* ws; int ph_lo, ph_hi, li, pad; };

struct Fr {
    LAS unsigned char* lds;
    int tid, lane, wave;
    const float* const* in;
    float* out; unsigned char* ws;
};

template <int MODE>
__device__ __forceinline__ void transpose_item(const float* W, int K, int N, bf16* WT, int row_off, LAS float* scr, int item, int lane) {
    const int nblk = N / 32, kb = item / nblk, nb = item % nblk, k0 = 64 * kb, n0 = 32 * nb;
#pragma unroll 8
    for (int i = 0; i < 32; ++i) { const int kk = 2 * i + (lane >> 5); scr[kk * 33 + (lane & 31)] = W[(size_t)(k0 + kk) * N + n0 + (lane & 31)]; }
    asm volatile("s_waitcnt lgkmcnt(0)" ::: "memory");
    const int c = lane & 7;
#pragma unroll
    for (int j = 0; j < 4; ++j) { const int n = (lane >> 3) + 8 * j; const LAS float* s = scr + (8 * c) * 33 + n;
        u32x4 o; o.x = pk2(s[0 * 33], s[1 * 33]); o.y = pk2(s[2 * 33], s[3 * 33]); o.z = pk2(s[4 * 33], s[5 * 33]); o.w = pk2(s[6 * 33], s[7 * 33]);
        int gn = n0 + n, drow;
        if (MODE == 0) drow = row_off + gn;
        else { const int up = gn >= DFF ? 1 : 0; const int nn = gn - up * DFF;
               const int pn = nn >> 7, wc = (nn >> 5) & 3, fq = (nn >> 3) & 3, bj = (nn >> 2) & 1, j = nn & 3; drow = 256 * pn + 128 * bj + 32 * wc + 16 * up + 4 * fq + j; }
        *(u32x4*)(WT + (size_t)drow * K + k0 + 8 * c) = o; }
    asm volatile("s_waitcnt lgkmcnt(0)" ::: "memory");
}
template <int MODE>
__device__ __forceinline__ void transpose_all(const float* W, int K, int N, bf16* WT, int row_off, LAS float* scr, int gw, int NGW, int lane) {
    const int ni = (K / 64) * (N / 32);
    for (int it = gw; it < ni; it += NGW) transpose_item<MODE>(W, K, N, WT, row_off, scr, it, lane);
}

__device__ __forceinline__ void ada_phase(const float* cp, const float* csmp, const float* wada, const float* bada, float* mod, LAS unsigned char* lds, int tid, int lane, int wave) {
    const int n0 = blockIdx.x * 144, layer = n0 / LMOD, nl0 = n0 % LMOD;
    const float* W = wada + (size_t)layer * D * LMOD + nl0;
    constexpr int BUF = 144 * 136 * 2 + 128 * 152 * 2;
    for (int i = tid; i < 2 * 12 * 136 / 2; i += 512) { const int bsel = i / (12 * 136 / 2), o = i % (12 * 136 / 2); ((LAS unsigned*)(lds + bsel * BUF + 132 * 136 * 2))[o] = 0u; }
    f32x4 wr[9], ar[9];
    f32x4 acc[9], accx = (f32x4){0.f, 0.f, 0.f, 0.f}, accy = (f32x4){0.f, 0.f, 0.f, 0.f};
#pragma unroll
    for (int m = 0; m < 9; ++m) acc[m] = (f32x4){0.f, 0.f, 0.f, 0.f};
#define ADA_LOAD(kc) do { _Pragma("unroll") for (int i = 0; i < 9; ++i) { const int idx = tid + 512 * i, row = idx / 36, c4 = idx % 36; wr[i] = *(const f32x4*)(W + (size_t)((kc) * 128 + row) * LMOD + 4 * c4); } \
        _Pragma("unroll") for (int i = 0; i < 9; ++i) { const int idx = tid + 512 * i, m = idx >> 5, k4 = idx & 31; ar[i] = (f32x4){0.f, 0.f, 0.f, 0.f}; \
            if (idx < 132 * 32) ar[i] = *(const f32x4*)((m < NB ? cp + (size_t)m * D : csmp + (size_t)(m - NB) * D) + (kc) * 128 + 4 * k4); } } while (0)
    ADA_LOAD(0);
#pragma unroll 1
    for (int kc = 0; kc < 16; ++kc) {
        LAS bf16* Ac = (LAS bf16*)(lds + (kc & 1) * BUF); LAS bf16* Wc = Ac + 144 * 136;
#pragma unroll
        for (int i = 0; i < 9; ++i) { const int idx = tid + 512 * i, row = idx / 36, c4 = idx % 36; u32x2 w; w.x = pk2(wr[i][0], wr[i][1]); w.y = pk2(wr[i][2], wr[i][3]); *(LAS u32x2*)(Wc + row * 152 + 4 * c4) = w; }
#pragma unroll
        for (int i = 0; i < 9; ++i) { const int idx = tid + 512 * i, m = idx >> 5, k4 = idx & 31;
            if (idx < 132 * 32) { u32x2 w; w.x = pk2(silu_fast(ar[i][0]), silu_fast(ar[i][1])); w.y = pk2(silu_fast(ar[i][2]), silu_fast(ar[i][3])); *(LAS u32x2*)(Ac + m * 136 + 4 * k4) = w; } }
        if (kc + 1 < 16) ADA_LOAD(kc + 1);
        LDS_BARRIER();
#pragma unroll
        for (int m = 0; m < 9; ++m) mma_tile2<128, false, true>(acc[m], Ac + m * 16 * 136, 136, Wc + wave * 16, 152, lane);
        mma_tile2<128, false, true>(accx, Ac + wave * 16 * 136, 136, Wc + 8 * 16, 152, lane);
        if (wave == 0) mma_tile2<128, false, true>(accy, Ac + 8 * 16 * 136, 136, Wc + 8 * 16, 152, lane);
    }
#undef ADA_LOAD
    const int fr = lane & 15, fq = lane >> 4;
    { const int n = n0 + 16 * wave + fr; const float bv = bada[n];
#pragma unroll
      for (int m = 0; m < 9; ++m)
#pragma unroll
          for (int ii = 0; ii < 4; ++ii) { const int row = 16 * m + 4 * fq + ii; if (row < NMB) mod[(size_t)row * NMOD + n] = acc[m][ii] + bv; } }
    { const int n = n0 + 128 + fr; const float bv = bada[n];
#pragma unroll
      for (int ii = 0; ii < 4; ++ii) { const int row = 16 * wave + 4 * fq + ii; if (row < NMB) mod[(size_t)row * NMOD + n] = accx[ii] + bv; }
      if (wave == 0) {
#pragma unroll
          for (int ii = 0; ii < 4; ++ii) { const int row = 128 + 4 * fq + ii; if (row < NMB) mod[(size_t)row * NMOD + n] = accy[ii] + bv; } } }
    LDS_BARRIER();
}

__device__ __forceinline__ void prep_phase(const Args& a, LAS unsigned char* lds, int tid, int lane, int wave) {
    ada_phase(a.in[2], a.in[3], a.in[7], a.in[8], (float*)(a.ws + WS_MOD), lds, tid, lane, wave);
    LAS float* scr = (LAS float*)(lds + wave * 8448);
    const int gw = blockIdx.x * 8 + wave, NGW = gridDim.x * 8;
    unsigned char* ws = a.ws;
#pragma unroll 1
    for (int i = 0; i < 4; ++i) {
        transpose_all<1>(a.in[11] + (size_t)i * D * NGU, D, NGU, (bf16*)(ws + WS_WGU + i * SZ_WGU), 0, scr, gw, NGW, lane);
        transpose_all<0>(a.in[12] + (size_t)i * DFF * D, DFF, D, (bf16*)(ws + WS_WDN + i * SZ_WDN), 0, scr, gw, NGW, lane);
    }
    transpose_all<0>(a.in[13], D, RIN, (bf16*)(ws + WS_WRI), 0, scr, gw, NGW, lane);
    transpose_all<0>(a.in[14], RV, D, (bf16*)(ws + WS_WRO), 0, scr, gw, NGW, lane);
    transpose_all<0>(a.in[15], D, GIN, (bf16*)(ws + WS_WGI), 0, scr, gw, NGW, lane);
    transpose_all<0>(a.in[20], RV, D, (bf16*)(ws + WS_WGO), 0, scr, gw, NGW, lane);
    const size_t gt = (size_t)blockIdx.x * 512 + tid, GT = (size_t)gridDim.x * 512;
    { unsigned* z = (unsigned*)(ws + WS_WGI + (size_t)GIN * D * 2); const size_t nz = (size_t)(GINP - GIN) * D / 2; for (size_t i = gt; i < nz; i += GT) z[i] = 0u; }
    { f32x2* rot = (f32x2*)(ws + WS_ROT);
      for (size_t i = gt; i < (size_t)2056 * 128; i += GT) { const int p = (int)(i >> 7), j = (int)(i & 127); const int pos = p < SEQ ? p : PAST + (p - SEQ);
          const float t = (float)j / 127.0f; const float pw = (float)exp((double)t * 9.210340371976184); const float inv = 1.0f / pw;
          const float ang = (float)pos * inv; double s, c; sincos_d((double)ang, s, c); rot[i] = (f32x2){(float)c, (float)s}; } }
}

struct ThinRaw { u32x4 x[4], y[4]; };
template <bool FIRST_SRC, bool HAS_Y>
__device__ __forceinline__ void thin_load(ThinRaw& R, int r, const float* xp, const float* xs, const bf16* xb, const bf16* y, const bf16* ys, int lane) {
    if (FIRST_SRC) { const float* xr = (r < MP ? xp + (size_t)r * D : xs + (size_t)(r - MP) * D) + 8 * lane;
#pragma unroll
        for (int j = 0; j < 4; ++j) { const f32x4 a = *(const f32x4*)(xr + 512 * j), b2 = *(const f32x4*)(xr + 512 * j + 4);
            R.x[j].x = pk2(a[0], a[1]); R.x[j].y = pk2(a[2], a[3]); R.x[j].z = pk2(b2[0], b2[1]); R.x[j].w = pk2(b2[2], b2[3]); }
    } else { const bf16* xr = xb + (size_t)r * D + 8 * lane;
#pragma unroll
        for (int j = 0; j < 4; ++j) R.x[j] = *(const u32x4*)(xr + 512 * j); }
    if (HAS_Y) {
        if (ys != nullptr && r >= MP) { const bf16* yp = ys + (size_t)(r - MP) * D + 8 * lane;
#pragma unroll
            for (int j = 0; j < 4; ++j) { float a[8]; unpack8(*(const u32x4*)(yp + 512 * j), a);
#pragma unroll
                for (int s = 1; s < 8; ++s) { float t[8]; unpack8(*(const u32x4*)(yp + (size_t)s * MS * D + 512 * j), t);
#pragma unroll
                    for (int e = 0; e < 8; ++e) a[e] += t[e]; }
                R.y[j] = pack8(a); }
        } else { const bf16* yr = y + (size_t)r * D + 8 * lane;
#pragma unroll
            for (int j = 0; j < 4; ++j) R.y[j] = *(const u32x4*)(yr + 512 * j); }
    }
}
template <bool FIRST_SRC, bool HAS_Y, bool HAS_NEXT, bool LAST>
__device__ __forceinline__ void thin_phase(const float* xp, const float* xs, bf16* xb, float* out, const bf16* y, const bf16* ys, const float* mod, const float* wpost, int off_gate, float res_scale,
                                           const float* wpre, int off_shift, bf16* h, LAS unsigned char* lds, int tid, int lane, int wave) {
    asm volatile("" : "+v"(tid), "+v"(lane));
    LAS float* Wp = (LAS float*)lds;
    LAS float* Mv = Wp + 4096;
    const int gw = blockIdx.x * 8 + wave;
    const int nit = blockIdx.x < 128 ? 5 : 4;
    { const f32x4 a0 = *(const f32x4*)(wpost + 4 * tid), a1 = *(const f32x4*)(wpre + 4 * tid);
      f32x4 mm[5][3];
#pragma unroll
      for (int k = 0; k < 5; ++k) { const int mbn = (k < 4) ? k : NB + (int)blockIdx.x; const float* modr = mod + (size_t)mbn * NMOD;
          if (k < nit) { mm[k][0] = *(const f32x4*)(modr + off_gate + 4 * tid); mm[k][1] = *(const f32x4*)(modr + off_shift + 4 * tid); mm[k][2] = *(const f32x4*)(modr + off_shift + D + 4 * tid); } }
      *(LAS f32x4*)(Wp + 4 * tid) = a0; *(LAS f32x4*)(Wp + 2048 + 4 * tid) = a1;
#pragma unroll
      for (int k = 0; k < 5; ++k) if (k < nit) { LAS float* mn = Mv + k * 6144; *(LAS f32x4*)(mn + 4 * tid) = mm[k][0]; *(LAS f32x4*)(mn + 2048 + 4 * tid) = mm[k][1]; *(LAS f32x4*)(mn + 4096 + 4 * tid) = mm[k][2]; } }
    ThinRaw R[2];
    thin_load<FIRST_SRC, HAS_Y>(R[0], gw, xp, xs, xb, y, ys, lane);
    thin_load<FIRST_SRC, HAS_Y>(R[1], gw + 2048, xp, xs, xb, y, ys, lane);
    LDS_BARRIER();
#pragma unroll
    for (int k = 0; k < 5; ++k) { if (k < nit) {
        const int r = gw + 2048 * k;
        float x[32], yv[32];
#pragma unroll
        for (int j = 0; j < 4; ++j) { float t[8]; unpack8(R[k & 1].x[j], t);
#pragma unroll
            for (int e = 0; e < 8; ++e) x[8 * j + e] = t[e];
            if (HAS_Y) { unpack8(R[k & 1].y[j], t);
#pragma unroll
                for (int e = 0; e < 8; ++e) yv[8 * j + e] = t[e]; } }
#pragma unroll
        for (int j = 0; j < 32; ++j) { asm volatile("" : "+v"(x[j])); if (HAS_Y) asm volatile("" : "+v"(yv[j])); }
        if (k + 2 < nit) thin_load<FIRST_SRC, HAS_Y>(R[k & 1], r + 4096, xp, xs, xb, y, ys, lane);
        const LAS float* mv = Mv + k * 6144;
        if (HAS_Y) {
            float ss = 0.f;
#pragma unroll
            for (int j = 0; j < 32; ++j) ss += yv[j] * yv[j];
            ss = wave_sum(ss); const float rstd = 1.0f / sqrtf(ss * (1.0f / D) + EPS);
#pragma unroll
            for (int j = 0; j < 4; ++j) { const int c = 8 * lane + 512 * j;
#pragma unroll
                for (int hq = 0; hq < 2; ++hq) { const f32x4 g = *(const LAS f32x4*)(mv + c + 4 * hq), w = *(const LAS f32x4*)(Wp + c + 4 * hq);
#pragma unroll
                    for (int e = 0; e < 4; ++e) x[8 * j + 4 * hq + e] += (res_scale * g[e]) * (yv[8 * j + 4 * hq + e] * rstd * w[e]); }
                if (LAST) { *(f32x4*)(out + (size_t)r * D + c) = (f32x4){x[8 * j], x[8 * j + 1], x[8 * j + 2], x[8 * j + 3]}; *(f32x4*)(out + (size_t)r * D + c + 4) = (f32x4){x[8 * j + 4], x[8 * j + 5], x[8 * j + 6], x[8 * j + 7]}; }
                else { u32x4 o; o.x = pk2(x[8 * j], x[8 * j + 1]); o.y = pk2(x[8 * j + 2], x[8 * j + 3]); o.z = pk2(x[8 * j + 4], x[8 * j + 5]); o.w = pk2(x[8 * j + 6], x[8 * j + 7]); *(u32x4*)(xb + (size_t)r * D + c) = o; } }
        }
        if (HAS_NEXT) {
            float ss = 0.f;
#pragma unroll
            for (int j = 0; j < 32; ++j) ss += x[j] * x[j];
            ss = wave_sum(ss); const float rstd = 1.0f / sqrtf(ss * (1.0f / D) + EPS);
#pragma unroll
            for (int j = 0; j < 4; ++j) { const int c = 8 * lane + 512 * j; float hv[8];
#pragma unroll
                for (int hq = 0; hq < 2; ++hq) { const f32x4 sh = *(const LAS f32x4*)(mv + 2048 + c + 4 * hq), sc = *(const LAS f32x4*)(mv + 4096 + c + 4 * hq), w = *(const LAS f32x4*)(Wp + 2048 + c + 4 * hq);
#pragma unroll
                    for (int e = 0; e < 4; ++e) hv[4 * hq + e] = (x[8 * j + 4 * hq + e] * rstd * w[e]) * (1.0f + sc[e]) + sh[e]; }
                *(u32x4*)(h + (size_t)r * D + c) = pack8(hv); }
        }
    } }
    LDS_BARRIER();
}

struct RetRegs { u32x4 qa[2][2], ka[2][2]; f32x4 rt[2][4]; u32x4 vv; };
__device__ __forceinline__ void ret_chunk_load(RetRegs& R, const bf16* P, const f32x2* ROT, int b, int h, int vs, int n, int tid) {
    const int r0 = b * SEQ + n * 64;
#pragma unroll
    for (int i = 0; i < 2; ++i) { const int rem = tid + 512 * i, row = rem >> 4, d0 = (rem & 15) * 8;
        const bf16* src = P + (size_t)(r0 + row) * RIN + h * 256;
        R.qa[i][0] = *(const u32x4*)(src + d0); R.qa[i][1] = *(const u32x4*)(src + 128 + d0);
        R.ka[i][0] = *(const u32x4*)(src + 2048 + d0); R.ka[i][1] = *(const u32x4*)(src + 2048 + 128 + d0);
        const f32x4* rp = (const f32x4*)(ROT + (size_t)(n * 64 + row) * 128 + d0);
#pragma unroll
        for (int j = 0; j < 4; ++j) R.rt[i][j] = rp[j]; }
    { const int row = tid >> 3, g8 = (tid & 7) * 8; R.vv = *(const u32x4*)(P + (size_t)(r0 + row) * RIN + 4096 + h * 512 + vs * 64 + g8); }
}
__device__ __forceinline__ void ret_prompt_item(int it, const bf16* P, const f32x2* ROT, bf16* OB, float* retp, LAS unsigned char* lds, int tid, int lane, int wave) {
    const int b = it >> 6, h = (it >> 3) & 7, vs = it & 7;
    LAS bf16* Qs = (LAS bf16*)lds;
    LAS bf16* Ks = Qs + 64 * 264;
    LAS bf16* STs = Ks + 64 * 264;
    LAS bf16* Vs = STs + 64 * 264;
    LAS bf16* VDs = Vs + 64 * 72;
    LAS bf16* SCs = VDs + 64 * 72;
    const float lg = log1pf(-exp2f(-5.0f - (float)h));
    const float cd = __expf(lg * 64.0f);
    f32x4 accS[8];
#pragma unroll
    for (int e = 0; e < 8; ++e) accS[e] = (f32x4){0.f, 0.f, 0.f, 0.f};
    const int fr = lane & 15, fq = lane >> 4;
    RetRegs R; ret_chunk_load(R, P, ROT, b, h, vs, 0, tid);
    for (int n = 0; n < 32; ++n) {
        const int r0 = b * SEQ + n * 64;
#pragma unroll
        for (int e = 0; e < 8; ++e) { const int T = wave * 8 + e, dt = T >> 2, vt = T & 3; u32x2 w; w.x = pk2(accS[e][0], accS[e][1]); w.y = pk2(accS[e][2], accS[e][3]);
            *(LAS u32x2*)(STs + (16 * vt + fr) * 264 + 16 * dt + 4 * fq) = w; }
#pragma unroll
        for (int i = 0; i < 2; ++i) { const int rem = tid + 512 * i, row = rem >> 4, d0 = (rem & 15) * 8;
#pragma unroll
            for (int which = 0; which < 2; ++which) {
                float x1[8], x2[8], y1[8], y2[8]; unpack8(which ? R.ka[i][0] : R.qa[i][0], x1); unpack8(which ? R.ka[i][1] : R.qa[i][1], x2);
#pragma unroll
                for (int j2 = 0; j2 < 4; ++j2) { const f32x4 cs = R.rt[i][j2];
                    y1[2 * j2] = x1[2 * j2] * cs[0] - x2[2 * j2] * cs[1]; y2[2 * j2] = x1[2 * j2] * cs[1] + x2[2 * j2] * cs[0];
                    y1[2 * j2 + 1] = x1[2 * j2 + 1] * cs[2] - x2[2 * j2 + 1] * cs[3]; y2[2 * j2 + 1] = x1[2 * j2 + 1] * cs[3] + x2[2 * j2 + 1] * cs[2]; }
                if (which == 0) {
#pragma unroll
                    for (int j = 0; j < 8; ++j) { y1[j] *= 0.0625f; y2[j] *= 0.0625f; }
                    *(LAS u32x4*)(Qs + row * 264 + d0) = pack8(y1); *(LAS u32x4*)(Qs + row * 264 + 128 + d0) = pack8(y2);
                } else { *(LAS u32x4*)(Ks + row * 264 + d0) = pack8(y1); *(LAS u32x4*)(Ks + row * 264 + 128 + d0) = pack8(y2); } } }
        { const int row = tid >> 3, g8 = (tid & 7) * 8; *(LAS u32x4*)(Vs + row * 72 + g8) = R.vv;
          float v[8]; unpack8(R.vv, v); const float kd = __expf(lg * (float)(63 - row));
#pragma unroll
          for (int j = 0; j < 8; ++j) v[j] *= kd;
          *(LAS u32x4*)(VDs + row * 72 + g8) = pack8(v); }
        if (n + 1 < 32) ret_chunk_load(R, P, ROT, b, h, vs, n + 1, tid);
        LDS_BARRIER();
        { const int itile = wave >> 1, jt0 = 2 * (wave & 1); bf16x8 qf[8]; f32x4 acc[2];
#pragma unroll
          for (int ks = 0; ks < 8; ++ks) qf[ks] = frag_n(Qs + itile * 16 * 264, 264, 32 * ks, lane);
#pragma unroll
          for (int e = 0; e < 2; ++e) { acc[e] = (f32x4){0.f, 0.f, 0.f, 0.f};
#pragma unroll
              for (int ks = 0; ks < 8; ++ks) acc[e] = MFMA16(frag_n(Ks + (jt0 + e) * 16 * 264, 264, 32 * ks, lane), qf[ks], acc[e]); }
#pragma unroll
          for (int e = 0; e < 2; ++e) { const int i = 16 * itile + fr, j0 = 16 * (jt0 + e) + 4 * fq; float v[4];
#pragma unroll
              for (int ii = 0; ii < 4; ++ii) { const int j = j0 + ii; v[ii] = (i >= j) ? acc[e][ii] * __expf(lg * (float)(i - j)) : 0.f; }
              u32x2 w; w.x = pk2(v[0], v[1]); w.y = pk2(v[2], v[3]); *(LAS u32x2*)(SCs + i * 72 + j0) = w; } }
        LDS_BARRIER();
        { const int vt = wave >> 1, it0 = 2 * (wave & 1); bf16x8 vf[2], sf[8]; f32x4 intra[2], inter[2];
#pragma unroll
          for (int ks = 0; ks < 2; ++ks) vf[ks] = frag_tr(Vs + vt * 16 + 32 * ks * 72, 72, lane);
#pragma unroll
          for (int ks = 0; ks < 8; ++ks) sf[ks] = frag_n(STs + vt * 16 * 264, 264, 32 * ks, lane);
#pragma unroll
          for (int e = 0; e < 2; ++e) { intra[e] = (f32x4){0.f, 0.f, 0.f, 0.f}; inter[e] = (f32x4){0.f, 0.f, 0.f, 0.f};
#pragma unroll
              for (int ks = 0; ks < 2; ++ks) intra[e] = MFMA16(vf[ks], frag_n(SCs + (it0 + e) * 16 * 72, 72, 32 * ks, lane), intra[e]);
#pragma unroll
              for (int ks = 0; ks < 8; ++ks) inter[e] = MFMA16(sf[ks], frag_n(Qs + (it0 + e) * 16 * 264, 264, 32 * ks, lane), inter[e]); }
          bf16x8 kf[2][2], vdf[4][2];
#pragma unroll
          for (int a = 0; a < 2; ++a)
#pragma unroll
              for (int ks = 0; ks < 2; ++ks) kf[a][ks] = frag_tr(Ks + (2 * wave + a) * 16 + 32 * ks * 264, 264, lane);
#pragma unroll
          for (int v4 = 0; v4 < 4; ++v4)
#pragma unroll
              for (int ks = 0; ks < 2; ++ks) vdf[v4][ks] = frag_tr(VDs + v4 * 16 + 32 * ks * 72, 72, lane);
#pragma unroll
          for (int e = 0; e < 8; ++e) { accS[e] = accS[e] * cd;
#pragma unroll
              for (int ks = 0; ks < 2; ++ks) accS[e] = MFMA16(kf[e >> 2][ks], vdf[e & 3][ks], accS[e]); }
#pragma unroll
          for (int e = 0; e < 2; ++e) { const int i = 16 * (it0 + e) + fr, v0 = 16 * vt + 4 * fq; const float qd = __expf(lg * (float)(i + 1));
              const f32x4 ov = intra[e] + qd * inter[e]; u32x2 w; w.x = pk2(ov[0], ov[1]); w.y = pk2(ov[2], ov[3]); *(u32x2*)(OB + (size_t)(r0 + i) * RV + h * 512 + vs * 64 + v0) = w; } }
        LDS_BARRIER();
    }
#pragma unroll
    for (int e = 0; e < 8; ++e) { const int T = wave * 8 + e, dt = T >> 2, vt = T & 3;
#pragma unroll
        for (int ii = 0; ii < 4; ++ii) retp[((size_t)(b * 8 + h) * 256 + 16 * dt + 4 * fq + ii) * 512 + vs * 64 + 16 * vt + fr] = accS[e][ii]; }
}

__device__ __forceinline__ void ret_sample_item(int it, const bf16* P, const f32x2* ROT, const float* S0, bf16* OB, float* rets, LAS unsigned char* lds, int tid, int lane, int wave) {
    const int b = it >> 3, h = it & 7;
    LAS float* QsT = (LAS float*)lds;
    LAS float* KdT = QsT + 2048;
    LAS float* Qf = KdT + 2048;
    LAS float* Kf = Qf + 2048;
    LAS float* As = Kf + 2048;
    LAS float* red = As + 64;
    const float lg = log1pf(-exp2f(-5.0f - (float)h));
    const int rbase = MP + b * DSEQ;
#pragma unroll 1
    for (int i = 0; i < 4; ++i) { const int idx = tid + 512 * i, which = idx >> 10, rem = idx & 1023, n = rem >> 7, j = rem & 127;
        const bf16* src = P + (size_t)(rbase + n) * RIN + which * 2048 + h * 256;
        const float x1 = bf2f(src[j]), x2 = bf2f(src[128 + j]); const f32x2 cs = ROT[(size_t)(SEQ + n) * 128 + j];
        float y1 = x1 * cs[0] - x2 * cs[1], y2 = x1 * cs[1] + x2 * cs[0];
        if (which == 0) { y1 *= 0.0625f; y2 *= 0.0625f; QsT[j * 8 + n] = y1; QsT[(128 + j) * 8 + n] = y2; Qf[n * 256 + j] = y1; Qf[n * 256 + 128 + j] = y2; }
        else { const float kd = __expf(lg * (float)(7 - n)); KdT[j * 8 + n] = y1 * kd; KdT[(128 + j) * 8 + n] = y2 * kd; Kf[n * 256 + j] = y1; Kf[n * 256 + 128 + j] = y2; } }
    const int vq = tid & 127, dg = tid >> 7;
    f32x4 vreg[8];
#pragma unroll
    for (int n = 0; n < 8; ++n) { const u32x2 w = *(const u32x2*)(P + (size_t)(rbase + n) * RIN + 4096 + h * 512 + 4 * vq); vreg[n] = (f32x4){bflo(w.x), bfhi(w.x), bflo(w.y), bfhi(w.y)}; }
    LDS_BARRIER();
    { const int p = tid >> 3, part = tid & 7, n = p >> 3, m = p & 7; float s = 0.f;
#pragma unroll 8
      for (int d = 0; d < 32; ++d) s += Qf[n * 256 + part * 32 + d] * Kf[m * 256 + part * 32 + d];
      s += __shfl_xor(s, 1); s += __shfl_xor(s, 2); s += __shfl_xor(s, 4);
      if (part == 0) As[n * 8 + m] = (m <= n) ? s * __expf(lg * (float)(n - m)) : 0.f; }
    LDS_BARRIER();
    f32x4 oi[8];
#pragma unroll
    for (int n = 0; n < 8; ++n) oi[n] = (f32x4){0.f, 0.f, 0.f, 0.f};
    const float g8 = __expf(lg * 8.0f);
    const float* sp = S0 + ((size_t)(b * 8 + h) * 256 + dg * 64) * 512 + 4 * vq;
    float* dp = rets + ((size_t)(b * 8 + h) * 256 + dg * 64) * 512 + 4 * vq;
    f32x4 sc[8], sn[8];
#pragma unroll
    for (int u = 0; u < 8; ++u) sc[u] = *(const f32x4*)(sp + (size_t)u * 512);
#pragma unroll 1
    for (int d0 = 0; d0 < 64; d0 += 8) {
        if (d0 + 8 < 64) {
#pragma unroll
            for (int u = 0; u < 8; ++u) sn[u] = *(const f32x4*)(sp + (size_t)(d0 + 8 + u) * 512); }
#pragma unroll
        for (int u = 0; u < 8; ++u) { const int d = dg * 64 + d0 + u;
            const f32x4 s4 = sc[u];
            const f32x4 qa = *(const LAS f32x4*)(QsT + d * 8), qb = *(const LAS f32x4*)(QsT + d * 8 + 4), ka = *(const LAS f32x4*)(KdT + d * 8), kb = *(const LAS f32x4*)(KdT + d * 8 + 4);
            f32x4 snw = s4 * g8;
#pragma unroll
            for (int n = 0; n < 4; ++n) { oi[n] += qa[n] * s4; oi[n + 4] += qb[n] * s4; snw += ka[n] * vreg[n]; snw += kb[n] * vreg[n + 4]; }
            *(f32x4*)(dp + (size_t)(d0 + u) * 512) = snw; }
#pragma unroll
        for (int u = 0; u < 8; ++u) sc[u] = sn[u];
    }
#pragma unroll
    for (int n = 0; n < 8; ++n) *(LAS f32x4*)(red + (dg * 8 + n) * 512 + 4 * vq) = oi[n];
    LDS_BARRIER();
#pragma unroll
    for (int nn = 0; nn < 2; ++nn) { const int n = 2 * dg + nn;
        f32x4 o = *(const LAS f32x4*)(red + (0 * 8 + n) * 512 + 4 * vq) + *(const LAS f32x4*)(red + (1 * 8 + n) * 512 + 4 * vq) + *(const LAS f32x4*)(red + (2 * 8 + n) * 512 + 4 * vq) + *(const LAS f32x4*)(red + (3 * 8 + n) * 512 + 4 * vq);
        o = o * __expf(lg * (float)(n + 1));
#pragma unroll
        for (int m = 0; m < 8; ++m) o += As[n * 8 + m] * vreg[m];
        { u32x2 w; w.x = pk2(o[0], o[1]); w.y = pk2(o[2], o[3]); *(u32x2*)(OB + (size_t)(rbase + n) * RV + h * 512 + 4 * vq) = w; } }
    LDS_BARRIER();
}

__device__ __forceinline__ void ret_norm_phase(const bf16* OB, const bf16* P, bf16* AO, int lane, int wave) {
    const int gw = blockIdx.x * 8 + wave, NGW = gridDim.x * 8;
    for (int it0 = gw; it0 < M * 8; it0 += 4 * NGW) {
        u32x4 ov[4], gv[4];
#pragma unroll
        for (int u = 0; u < 4; ++u) { const int it = it0 + u * NGW; ov[u] = (u32x4){0u, 0u, 0u, 0u}; gv[u] = ov[u];
            if (it < M * 8) { const int r = it >> 3, h = it & 7; ov[u] = *(const u32x4*)(OB + (size_t)r * RV + h * 512 + 8 * lane); gv[u] = *(const u32x4*)(P + (size_t)r * RIN + 8192 + h * 512 + 8 * lane); } }
#pragma unroll
        for (int u = 0; u < 4; ++u) { const int it = it0 + u * NGW;
            if (it < M * 8) { const int r = it >> 3, h = it & 7; float o[8], g[8]; unpack8(ov[u], o); unpack8(gv[u], g);
                float ss = 0.f;
#pragma unroll
                for (int j = 0; j < 8; ++j) ss += o[j] * o[j];
                ss = wave_sum(ss); const float rstd = 1.0f / sqrtf(ss * (1.0f / 512.0f) + EPS);
                float r8[8];
#pragma unroll
                for (int j = 0; j < 8; ++j) r8[j] = silu_fast(g[j]) * o[j] * rstd;
                *(u32x4*)(AO + (size_t)r * RV + h * 512 + 8 * lane) = pack8(r8); } }
    }
}

__device__ __forceinline__ void mm16_f32(f32x4& acc, const LAS float* X, int ldx, const LAS float* Y, int ldy, int lane) {
    const int i = lane & 15, kq = lane >> 4;
#pragma unroll
    for (int s = 0; s < 4; ++s) { const float av = X[i * ldx + 4 * s + kq]; const float bv = Y[(4 * s + kq) * ldy + i]; acc = __builtin_amdgcn_mfma_f32_16x16x4f32(av, bv, acc, 0, 0, 0); }
}
__device__ __forceinline__ void f1_raw_load(u32x4 (&rv)[7], float& av, float& bv, const bf16* P, const float* AB, int b, int hv, int n, int tid, int lane) {
    const int hk = hv >> 1;
#pragma unroll
    for (int i = 0; i < 7; ++i) { const int idx = tid + 512 * i, row = idx / 48, ck = idx % 48, ct = ck >> 4, c8 = (ck & 15) * 8;
        const int ch0 = (ct == 0 ? hk * 128 : ct == 1 ? 2048 + hk * 128 : 4096 + hv * 128) + c8; const int tt = n * 64 + row - 3;
        rv[i] = (u32x4){0u, 0u, 0u, 0u};
        if (idx < 67 * 48 && tt >= 0) rv[i] = *(const u32x4*)(P + (size_t)(b * SEQ + tt) * GINP + ch0); }
    const int r0 = b * SEQ + n * 64; av = AB[(size_t)(r0 + lane) * 64 + hv]; bv = AB[(size_t)(r0 + lane) * 64 + 32 + hv];
}
__device__ __forceinline__ void gdn_f1_block(const bf16* P, const float* AB, const float* convw, const float* alog, const float* dtb, unsigned char* f1buf, float* GL,
                                             LAS unsigned char* lds, int tid, int lane, int wave) {
    const int it0 = (int)blockIdx.x * 16, hv = (it0 >> 5) & 31, b = it0 >> 10, hk = hv >> 1;
    LAS bf16* RAW = (LAS bf16*)lds;
    LAS float* Lf = (LAS float*)lds;
    LAS float* TF = (LAS float*)(lds + 17408);
    LAS bf16* TB = (LAS bf16*)(lds + 34816);
    LAS float* Zs = (LAS float*)(lds + 44032);
    LAS bf16* QN = (LAS bf16*)(lds + 51456);
    LAS bf16* KN = QN + 64 * 136;
    LAS bf16* VB = KN + 64 * 136;
    LAS bf16* KBG = VB + 64 * 136;
    LAS float* WT = (LAS float*)(KBG + 64 * 136);
    LAS float* gcs = WT + 4 * 384;
    LAS float* bts = gcs + 64;
    if (tid < 384) { const int ct = tid >> 7, cc = tid & 127; const int ch = (ct == 0 ? hk * 128 : ct == 1 ? 2048 + hk * 128 : 4096 + hv * 128) + cc;
#pragma unroll
        for (int tap = 0; tap < 4; ++tap) WT[tap * 384 + tid] = convw[tap * CONVCH + ch]; }
    const float nexpa = -__expf(alog[hv]), dtbv = dtb[hv];
    u32x4 rv[7]; float av, bv;
    f1_raw_load(rv, av, bv, P, AB, b, hv, it0 & 31, tid, lane);
#pragma unroll 1
    for (int kk = 0; kk < 16; ++kk) {
    const int it = it0 + kk, n = it & 31;
    unsigned char* ib = f1buf + (size_t)it * F1_ITEM;
    bf16* gQG = (bf16*)(ib + F1_QG); bf16* gW = (bf16*)(ib + F1_W); bf16* gUT = (bf16*)(ib + F1_UT); bf16* gKD = (bf16*)(ib + F1_KDT); bf16* gATT = (bf16*)(ib + F1_ATT);
    const int fr = lane & 15, fq = lane >> 4;
    { if (wave == 7) { float g = nexpa * softplus_f(av + dtbv);
#pragma unroll
          for (int o = 1; o < 64; o <<= 1) { const float t = __shfl_up(g, o); if (lane >= o) g += t; }
          gcs[lane] = g; bts[lane] = sigmoid_f(bv);
          if (lane == 63) GL[it] = __expf(g); }
#pragma unroll
      for (int i = 0; i < 7; ++i) { const int idx = tid + 512 * i; if (idx < 67 * 48) *(LAS u32x4*)(RAW + (idx / 48) * 384 + (idx % 48) * 8) = rv[i]; }
      if (kk + 1 < 16) f1_raw_load(rv, av, bv, P, AB, b, hv, n + 1, tid, lane); }
    LDS_BARRIER();
    const float gc63 = gcs[63];
    { const int g = tid & 31, isk = g >> 4, g8 = (g & 15) * 8, cb = isk * 128 + g8;
      f32x4 cw[4][2];
#pragma unroll
      for (int tap = 0; tap < 4; ++tap) { cw[tap][0] = *(const LAS f32x4*)(WT + tap * 384 + cb); cw[tap][1] = *(const LAS f32x4*)(WT + tap * 384 + cb + 4); }
#pragma unroll 1
    for (int i = 0; i < 4; ++i) { const int id = tid + 512 * i, row = id >> 5;
        float acc[8];
#pragma unroll
        for (int j = 0; j < 8; ++j) acc[j] = 0.f;
#pragma unroll
        for (int tap = 0; tap < 4; ++tap) { float xv[8]; unpack8(*(const LAS u32x4*)(RAW + (row + tap) * 384 + cb), xv);
#pragma unroll
            for (int j = 0; j < 4; ++j) { acc[j] += xv[j] * cw[tap][0][j]; acc[4 + j] += xv[4 + j] * cw[tap][1][j]; } }
        float ss = 0.f;
#pragma unroll
        for (int j = 0; j < 8; ++j) { acc[j] = silu_fast(acc[j]); ss += acc[j] * acc[j]; }
        ss += __shfl_xor(ss, 1); ss += __shfl_xor(ss, 2); ss += __shfl_xor(ss, 4); ss += __shfl_xor(ss, 8);
        const float gc = gcs[row], eg = __expf(gc);
        if (isk == 0) { const float rq = (1.0f / sqrtf(ss + EPS)) * 0.08838834764831845f; float qn[8], qg[8];
#pragma unroll
            for (int j = 0; j < 8; ++j) { qn[j] = acc[j] * rq; qg[j] = qn[j] * eg; }
            *(LAS u32x4*)(QN + row * 136 + g8) = pack8(qn); *(u32x4*)(gQG + row * 128 + g8) = pack8(qg); }
        else { const float rk = 1.0f / sqrtf(ss + EPS), bt = bts[row], egl = __expf(gc63 - gc); float kn[8], kb[8], kd[8];
#pragma unroll
            for (int j = 0; j < 8; ++j) { kn[j] = acc[j] * rk; kb[j] = kn[j] * (bt * eg); kd[j] = kn[j] * egl; }
            *(LAS u32x4*)(KN + row * 136 + g8) = pack8(kn); *(LAS u32x4*)(KBG + row * 136 + g8) = pack8(kb); *(u32x4*)(gKD + row * 128 + g8) = pack8(kd); } } }
    { const int g8 = (tid & 15) * 8, cb = 256 + g8;
      f32x4 cw[4][2];
#pragma unroll
      for (int tap = 0; tap < 4; ++tap) { cw[tap][0] = *(const LAS f32x4*)(WT + tap * 384 + cb); cw[tap][1] = *(const LAS f32x4*)(WT + tap * 384 + cb + 4); }
#pragma unroll 1
    for (int i = 0; i < 2; ++i) { const int id = tid + 512 * i, row = id >> 4;
        float acc[8];
#pragma unroll
        for (int j = 0; j < 8; ++j) acc[j] = 0.f;
#pragma unroll
        for (int tap = 0; tap < 4; ++tap) { float xv[8]; unpack8(*(const LAS u32x4*)(RAW + (row + tap) * 384 + cb), xv);
#pragma unroll
            for (int j = 0; j < 4; ++j) { acc[j] += xv[j] * cw[tap][0][j]; acc[4 + j] += xv[4 + j] * cw[tap][1][j]; } }
        const float bt = bts[row]; float vb[8];
#pragma unroll
        for (int j = 0; j < 8; ++j) vb[j] = silu_fast(acc[j]) * bt;
        *(LAS u32x4*)(VB + row * 136 + g8) = pack8(vb); } }
    LDS_BARRIER();
    { const int itile = wave >> 1, jt0 = 2 * (wave & 1); bf16x8 kif[4], qif[4]; f32x4 kk[2], qk[2];
#pragma unroll
      for (int ks = 0; ks < 4; ++ks) { kif[ks] = frag_n(KN + itile * 16 * 136, 136, 32 * ks, lane); qif[ks] = frag_n(QN + itile * 16 * 136, 136, 32 * ks, lane); }
#pragma unroll
      for (int e = 0; e < 2; ++e) { kk[e] = (f32x4){0.f, 0.f, 0.f, 0.f}; qk[e] = (f32x4){0.f, 0.f, 0.f, 0.f};
#pragma unroll
          for (int ks = 0; ks < 4; ++ks) { const bf16x8 kj = frag_n(KN + (jt0 + e) * 16 * 136, 136, 32 * ks, lane); kk[e] = MFMA16(kj, kif[ks], kk[e]); qk[e] = MFMA16(kj, qif[ks], qk[e]); } }
#pragma unroll
      for (int e = 0; e < 2; ++e) { const int i = 16 * itile + fr, j0 = 16 * (jt0 + e) + 4 * fq; const float gi = gcs[i], bi = bts[i]; float lv[4], av[4];
#pragma unroll
          for (int ii = 0; ii < 4; ++ii) { const int j = j0 + ii; const float dec = (j <= i) ? __expf(gi - gcs[j]) : 0.f; lv[ii] = (j < i) ? bi * kk[e][ii] * dec : 0.f; av[ii] = qk[e][ii] * dec; }
          *(LAS f32x4*)(Lf + i * 68 + j0) = (f32x4){lv[0], lv[1], lv[2], lv[3]};
          u32x2 w; w.x = pk2(av[0], av[1]); w.y = pk2(av[2], av[3]); *(u32x2*)(gATT + i * 64 + j0) = w; } }
    LDS_BARRIER();
    if (wave == 0) {
        const int blk = lane >> 4, c = lane & 15;
        { float t[16];
#pragma unroll
          for (int r = 0; r < 16; ++r) { float s = (r == c) ? 1.f : 0.f;
#pragma unroll
              for (int k = 0; k < r; ++k) s -= Lf[(16 * blk + r) * 68 + 16 * blk + k] * t[k];
              t[r] = s; TF[(16 * blk + r) * 68 + 16 * blk + c] = s; } }
#pragma unroll
        for (int lev = 1; lev < 4; ++lev) {
#pragma unroll
            for (int bj = 0; bj + lev < 4; ++bj) { const int bi = bj + lev; f32x4 z = (f32x4){0.f, 0.f, 0.f, 0.f};
#pragma unroll
                for (int bk = bj; bk < bi; ++bk) mm16_f32(z, Lf + (16 * bi) * 68 + 16 * bk, 68, TF + (16 * bk) * 68 + 16 * bj, 68, lane);
#pragma unroll
                for (int r = 0; r < 4; ++r) Zs[(4 * blk + r) * 17 + c] = z[r];
                f32x4 tn = (f32x4){0.f, 0.f, 0.f, 0.f};
                mm16_f32(tn, TF + (16 * bi) * 68 + 16 * bi, 68, Zs, 17, lane);
#pragma unroll
                for (int r = 0; r < 4; ++r) TF[(16 * bi + 4 * blk + r) * 68 + 16 * bj + c] = -tn[r]; } }
        { const int i = lane, ib2 = lane >> 4;
#pragma unroll
          for (int jb = 0; jb < 4; ++jb) { float v[16];
#pragma unroll
              for (int q4 = 0; q4 < 4; ++q4) { const f32x4 x = *(const LAS f32x4*)(TF + i * 68 + 16 * jb + 4 * q4); v[4 * q4] = x[0]; v[4 * q4 + 1] = x[1]; v[4 * q4 + 2] = x[2]; v[4 * q4 + 3] = x[3]; }
              const bool on = jb <= ib2;
              u32x4 w0, w1;
              w0.x = on ? pk2(v[0], v[1]) : 0u; w0.y = on ? pk2(v[2], v[3]) : 0u; w0.z = on ? pk2(v[4], v[5]) : 0u; w0.w = on ? pk2(v[6], v[7]) : 0u;
              w1.x = on ? pk2(v[8], v[9]) : 0u; w1.y = on ? pk2(v[10], v[11]) : 0u; w1.z = on ? pk2(v[12], v[13]) : 0u; w1.w = on ? pk2(v[14], v[15]) : 0u;
              *(LAS u32x4*)(TB + i * 72 + 16 * jb) = w0; *(LAS u32x4*)(TB + i * 72 + 16 * jb + 8) = w1; } }
    }
    LDS_BARRIER();
    { bf16x8 vbf[2], kbf[2]; f32x4 au[4], aw[4];
#pragma unroll
      for (int ks = 0; ks < 2; ++ks) { vbf[ks] = frag_tr(VB + wave * 16 + 32 * ks * 136, 136, lane); kbf[ks] = frag_tr(KBG + wave * 16 + 32 * ks * 136, 136, lane); }
#pragma unroll
      for (int e = 0; e < 4; ++e) { au[e] = (f32x4){0.f, 0.f, 0.f, 0.f}; aw[e] = (f32x4){0.f, 0.f, 0.f, 0.f};
#pragma unroll
          for (int ks = 0; ks < 2; ++ks) { const bf16x8 tf = frag_n(TB + e * 16 * 72, 72, 32 * ks, lane);
              au[e] = MFMA16(tf, vbf[ks], au[e]);
              aw[e] = MFMA16(kbf[ks], tf, aw[e]); } }
#pragma unroll
      for (int e = 0; e < 4; ++e) { u32x2 w; w.x = pk2(au[e][0], au[e][1]); w.y = pk2(au[e][2], au[e][3]); *(u32x2*)(gUT + (16 * wave + fr) * 64 + 16 * e + 4 * fq) = w;
          w.x = pk2(aw[e][0], aw[e][1]); w.y = pk2(aw[e][2], aw[e][3]); *(u32x2*)(gW + (16 * e + fr) * 128 + 16 * wave + 4 * fq) = w; } }
    LDS_BARRIER();
    }
}

struct F2Regs { u32x4 w[2], qg[2], kd[2], att, z[2]; u32x2 ut[4]; float gl; };
__device__ __forceinline__ void f2_load(F2Regs& R, const unsigned char* f1buf, const float* GL, const bf16* P, int it, int n, int tid, int lane, int wave) {
    const int item = it * 32 + n; const unsigned char* ib = f1buf + (size_t)item * F1_ITEM; const int b = it >> 5, hv = it & 31;
    const u32x4* s = (const u32x4*)(ib + F1_W); R.w[0] = s[tid]; R.w[1] = s[tid + 512];
    s = (const u32x4*)(ib + F1_QG); R.qg[0] = s[tid]; R.qg[1] = s[tid + 512];
    s = (const u32x4*)(ib + F1_KDT); R.kd[0] = s[tid]; R.kd[1] = s[tid + 512];
    s = (const u32x4*)(ib + F1_ATT); R.att = s[tid];
    const bf16* gUT = (const bf16*)(ib + F1_UT); const int fr = lane & 15, fq = lane >> 4;
#pragma unroll
    for (int e = 0; e < 4; ++e) { const int t = wave * 4 + e, ctile = t & 3, vt = t >> 2; R.ut[e] = *(const u32x2*)(gUT + (16 * vt + fr) * 64 + 16 * ctile + 4 * fq); }
    { const int c = tid >> 3, part = tid & 7; const bf16* zp = P + (size_t)(b * SEQ + n * 64 + c) * GINP + 8192 + hv * 128 + part * 16; R.z[0] = *(const u32x4*)zp; R.z[1] = *(const u32x4*)(zp + 8); }
    R.gl = GL[item];
}
__device__ __forceinline__ void gdn_f2_item(int it, const unsigned char* f1buf, const float* GL, const bf16* P, const float* normw, bf16* AO, float* gdnp,
                                            LAS unsigned char* lds, int tid, int lane, int wave) {
    const int b = it >> 5, hv = it & 31;
    LAS bf16* STs = (LAS bf16*)lds;
    LAS bf16* Ws = STs + 128 * 136;
    LAS bf16* QGs = Ws + 64 * 136;
    LAS bf16* KDs = QGs + 64 * 136;
    LAS bf16* ATs = KDs + 64 * 136;
    LAS bf16* VNTs = ATs + 64 * 72;
    LAS float* Os = (LAS float*)(VNTs + 128 * 72);
    const int fr = lane & 15, fq = lane >> 4;
    f32x4 accS[8];
#pragma unroll
    for (int e = 0; e < 8; ++e) accS[e] = (f32x4){0.f, 0.f, 0.f, 0.f};
    F2Regs R; f2_load(R, f1buf, GL, P, it, 0, tid, lane, wave);
    float nw[16];
    { const int part = tid & 7;
#pragma unroll
      for (int j = 0; j < 16; ++j) nw[j] = normw[part * 16 + j]; }
    for (int n = 0; n < 32; ++n) {
        const int r0 = b * SEQ + n * 64;
#pragma unroll
        for (int i = 0; i < 2; ++i) { const int idx = tid + 512 * i, row = idx >> 4, c8 = (idx & 15) * 8;
            *(LAS u32x4*)(Ws + row * 136 + c8) = R.w[i]; *(LAS u32x4*)(QGs + row * 136 + c8) = R.qg[i]; *(LAS u32x4*)(KDs + row * 136 + c8) = R.kd[i]; }
        { const int row = tid >> 3, c8 = (tid & 7) * 8; *(LAS u32x4*)(ATs + row * 72 + c8) = R.att; }
#pragma unroll
        for (int e = 0; e < 8; ++e) { const int T = wave * 8 + e, dt = T >> 3, vt = T & 7; u32x2 w; w.x = pk2(accS[e][0], accS[e][1]); w.y = pk2(accS[e][2], accS[e][3]);
            *(LAS u32x2*)(STs + (16 * vt + fr) * 136 + 16 * dt + 4 * fq) = w; }
        u32x2 utc[4]; u32x4 zc[2]; float gl = R.gl;
#pragma unroll
        for (int e = 0; e < 4; ++e) utc[e] = R.ut[e];
        zc[0] = R.z[0]; zc[1] = R.z[1];
        asm volatile("" : "+v"(utc[0]), "+v"(utc[1]), "+v"(utc[2]), "+v"(utc[3]), "+v"(zc[0]), "+v"(zc[1]), "+v"(gl));
        if (n + 1 < 32) f2_load(R, f1buf, GL, P, it, n + 1, tid, lane, wave);
        LDS_BARRIER();
        bf16x8 sf[4];
#pragma unroll
        for (int ks = 0; ks < 4; ++ks) sf[ks] = frag_n(STs + wave * 16 * 136, 136, 32 * ks, lane);
        { f32x4 acc[4];
#pragma unroll
          for (int e = 0; e < 4; ++e) { acc[e] = (f32x4){0.f, 0.f, 0.f, 0.f};
#pragma unroll
              for (int ks = 0; ks < 4; ++ks) acc[e] = MFMA16(frag_n(Ws + e * 16 * 136, 136, 32 * ks, lane), sf[ks], acc[e]); }
#pragma unroll
          for (int e = 0; e < 4; ++e) { const u32x2 uw = utc[e];
              u32x2 w; w.x = pk2(bflo(uw.x) - acc[e][0], bfhi(uw.x) - acc[e][1]); w.y = pk2(bflo(uw.y) - acc[e][2], bfhi(uw.y) - acc[e][3]);
              *(LAS u32x2*)(VNTs + (16 * wave + fr) * 72 + 16 * e + 4 * fq) = w; } }
        LDS_BARRIER();
        { f32x4 acc[4]; bf16x8 vf[2];
#pragma unroll
          for (int ks = 0; ks < 2; ++ks) vf[ks] = frag_n(VNTs + wave * 16 * 72, 72, 32 * ks, lane);
#pragma unroll
          for (int e = 0; e < 4; ++e) { acc[e] = (f32x4){0.f, 0.f, 0.f, 0.f};
#pragma unroll
              for (int ks = 0; ks < 4; ++ks) acc[e] = MFMA16(sf[ks], frag_n(QGs + e * 16 * 136, 136, 32 * ks, lane), acc[e]);
#pragma unroll
              for (int ks = 0; ks < 2; ++ks) acc[e] = MFMA16(vf[ks], frag_n(ATs + e * 16 * 72, 72, 32 * ks, lane), acc[e]); }
          bf16x8 kf[2];
#pragma unroll
          for (int ks = 0; ks < 2; ++ks) kf[ks] = frag_tr(KDs + wave * 16 + 32 * ks * 136, 136, lane);
#pragma unroll
          for (int e = 0; e < 8; ++e) { accS[e] = accS[e] * gl;
#pragma unroll
              for (int ks = 0; ks < 2; ++ks) accS[e] = MFMA16(kf[ks], frag_n(VNTs + e * 16 * 72, 72, 32 * ks, lane), accS[e]); }
#pragma unroll
          for (int e = 0; e < 4; ++e) *(LAS f32x4*)(Os + (16 * e + fr) * 132 + 16 * wave + 4 * fq) = acc[e]; }
        LDS_BARRIER();
        { const int c = tid >> 3, part = tid & 7; float o[16]; float ss = 0.f;
#pragma unroll
          for (int j = 0; j < 4; ++j) { const f32x4 v = *(const LAS f32x4*)(Os + c * 132 + part * 16 + 4 * j); o[4 * j] = v[0]; o[4 * j + 1] = v[1]; o[4 * j + 2] = v[2]; o[4 * j + 3] = v[3];
              ss += (v[0] * v[0] + v[1] * v[1]) + (v[2] * v[2] + v[3] * v[3]); }
          ss += __shfl_xor(ss, 1); ss += __shfl_xor(ss, 2); ss += __shfl_xor(ss, 4);
          const float rstd = 1.0f / sqrtf(ss * (1.0f / 128.0f) + EPS);
          float z[16]; { float t8[8]; unpack8(zc[0], t8);
#pragma unroll
              for (int j = 0; j < 8; ++j) z[j] = t8[j];
              unpack8(zc[1], t8);
#pragma unroll
              for (int j = 0; j < 8; ++j) z[8 + j] = t8[j]; }
          float r[16];
#pragma unroll
          for (int j = 0; j < 16; ++j) r[j] = o[j] * rstd * nw[j] * silu_fast(z[j]);
          bf16* ap = AO + (size_t)(r0 + c) * RV + hv * 128 + part * 16; u32x4 w;
          w.x = pk2(r[0], r[1]); w.y = pk2(r[2], r[3]); w.z = pk2(r[4], r[5]); w.w = pk2(r[6], r[7]); *(u32x4*)ap = w;
          w.x = pk2(r[8], r[9]); w.y = pk2(r[10], r[11]); w.z = pk2(r[12], r[13]); w.w = pk2(r[14], r[15]); *(u32x4*)(ap + 8) = w; }
    }
#pragma unroll
    for (int e = 0; e < 8; ++e) { const int T = wave * 8 + e, dt = T >> 3, vt = T & 7;
#pragma unroll
        for (int ii = 0; ii < 4; ++ii) gdnp[((size_t)it * 128 + 16 * dt + 4 * fq + ii) * 128 + 16 * vt + fr] = accS[e][ii]; }
    LDS_BARRIER();
}

__device__ __forceinline__ void gdn_sample_wave(int item, const bf16* P, const float* AB, const float* convw, const float* alog, const float* dtb, const float* normw,
                                                const float* S0, const float* cst, bf16* AO, float* gdns, LAS float* wl, int lane) {
    const int b = item >> 5, hv = item & 31, hk = hv >> 1;
    const int rbase = MP + b * DSEQ;
    const int cp = lane & 31, hh = lane >> 5;
    float a_l, b_l;
    { const int tk = lane & 7; const float av = AB[(size_t)(rbase + tk) * 64 + hv], bv = AB[(size_t)(rbase + tk) * 64 + 32 + hv];
      a_l = __expf(-__expf(alog[hv]) * softplus_f(av + dtb[hv])); b_l = sigmoid_f(bv); }
    float kq[8];
    {
      float qk[4][8];
#pragma unroll
      for (int j = 0; j < 4; ++j) { const int ch = (j < 2 ? hk * 128 : 2048 + hk * 128) + lane + 64 * (j & 1); float f[11], w[4];
#pragma unroll
          for (int i = 0; i < 3; ++i) f[i] = cst[((size_t)b * 3 + i) * CONVCH + ch];
#pragma unroll
          for (int i = 0; i < 8; ++i) f[3 + i] = bf2f(P[(size_t)(rbase + i) * GINP + ch]);
#pragma unroll
          for (int tap = 0; tap < 4; ++tap) w[tap] = convw[tap * CONVCH + ch];
#pragma unroll
          for (int tok = 0; tok < 8; ++tok) qk[j][tok] = silu_fast(f[tok] * w[0] + f[tok + 1] * w[1] + f[tok + 2] * w[2] + f[tok + 3] * w[3]); }
#pragma unroll
      for (int tok = 0; tok < 8; ++tok) {
          const float sq = wave_sum(qk[0][tok] * qk[0][tok] + qk[1][tok] * qk[1][tok]), sk = wave_sum(qk[2][tok] * qk[2][tok] + qk[3][tok] * qk[3][tok]);
          const float rq = (1.0f / sqrtf(sq + EPS)) * 0.08838834764831845f, rk = 1.0f / sqrtf(sk + EPS);
          const float q0 = qk[0][tok] * rq, q1 = qk[1][tok] * rq, k0 = qk[2][tok] * rk, k1 = qk[3][tok] * rk;
          kq[tok] = wave_sum(q0 * k0 + q1 * k1);
          wl[tok * 256 + lane] = q0; wl[tok * 256 + 64 + lane] = q1; wl[tok * 256 + 128 + lane] = k0; wl[tok * 256 + 192 + lane] = k1; } }
    const unsigned loff = (unsigned)((64 * hh) * 128 + 2 * cp);
#pragma unroll 1
    for (int half = 0; half < 2; ++half) {
#pragma unroll
        for (int c = 0; c < 2; ++c) { const int ch = 4096 + hv * 128 + half * 64 + 2 * cp + c; float f[11], w[4];
#pragma unroll
            for (int i = 0; i < 3; ++i) f[i] = cst[((size_t)b * 3 + i) * CONVCH + ch];
#pragma unroll
            for (int i = 0; i < 8; ++i) f[3 + i] = bf2f(P[(size_t)(rbase + i) * GINP + ch]);
#pragma unroll
            for (int tap = 0; tap < 4; ++tap) w[tap] = convw[tap * CONVCH + ch];
#pragma unroll
            for (int tok = 0; tok < 8; ++tok) wl[2048 + tok * 128 + 2 * lane + c] = silu_fast(f[tok] * w[0] + f[tok + 1] * w[1] + f[tok + 2] * w[2] + f[tok + 3] * w[3]); }
        asm volatile("" ::: "memory");
        f32x2 S[64];
        { const float* sp = S0 + (size_t)item * 16384 + half * 64;
#pragma unroll
          for (int d = 0; d < 64; ++d) S[d] = *(const f32x2*)(sp + d * 128 + loff); }
#pragma unroll
        for (int tok = 0; tok < 8; ++tok) {
            const LAS f32x4* qp = (const LAS f32x4*)(wl + tok * 256 + 64 * hh); const LAS f32x4* kp = (const LAS f32x4*)(wl + tok * 256 + 128 + 64 * hh);
            f32x2 kS = (f32x2){0.f, 0.f}, qS = (f32x2){0.f, 0.f}, kS1 = (f32x2){0.f, 0.f}, qS1 = (f32x2){0.f, 0.f};
#pragma unroll
            for (int j = 0; j < 16; ++j) { const f32x4 k4 = kp[j], q4 = qp[j];
                kS += k4[0] * S[4 * j] + k4[2] * S[4 * j + 2]; kS1 += k4[1] * S[4 * j + 1] + k4[3] * S[4 * j + 3];
                qS += q4[0] * S[4 * j] + q4[2] * S[4 * j + 2]; qS1 += q4[1] * S[4 * j + 1] + q4[3] * S[4 * j + 3];
                if ((j & 3) == 3) asm volatile("" ::: "memory"); }
            kS += kS1; qS += qS1;
            kS[0] += __shfl_xor(kS[0], 32); kS[1] += __shfl_xor(kS[1], 32); qS[0] += __shfl_xor(qS[0], 32); qS[1] += __shfl_xor(qS[1], 32);
            asm volatile("" ::: "memory");
            const float a = __shfl(a_l, tok), bt = __shfl(b_l, tok);
            const f32x2 vtk = *(const LAS f32x2*)(wl + 2048 + tok * 128 + 2 * lane);
            const f32x2 dv = bt * (vtk - a * kS);
            if (hh == 0) *(LAS f32x2*)(wl + 3072 + tok * 128 + half * 64 + 2 * cp) = a * qS + kq[tok] * dv;
#pragma unroll
            for (int j = 0; j < 16; ++j) { const f32x4 k4 = kp[j];
                S[4 * j] = a * S[4 * j] + k4[0] * dv; S[4 * j + 1] = a * S[4 * j + 1] + k4[1] * dv; S[4 * j + 2] = a * S[4 * j + 2] + k4[2] * dv; S[4 * j + 3] = a * S[4 * j + 3] + k4[3] * dv;
                if ((j & 7) == 7) asm volatile("" ::: "memory"); }
        }
        { float* dp = gdns + (size_t)item * 16384 + half * 64;
#pragma unroll
          for (int d = 0; d < 64; ++d) *(f32x2*)(dp + d * 128 + loff) = S[d]; }
    }
    { const f32x2 nw = *(const f32x2*)(normw + 2 * lane);
#pragma unroll
      for (int tok = 0; tok < 8; ++tok) { const f32x2 ov = *(const LAS f32x2*)(wl + 3072 + tok * 128 + 2 * lane);
          const float ss = wave_sum(ov[0] * ov[0] + ov[1] * ov[1]); const float rstd = 1.0f / sqrtf(ss * (1.0f / 128.0f) + EPS);
          const unsigned zw = *(const unsigned*)(P + (size_t)(rbase + tok) * GINP + 8192 + hv * 128 + 2 * lane);
          *(unsigned*)(AO + (size_t)(rbase + tok) * RV + hv * 128 + 2 * lane) = pk2(ov[0] * rstd * nw[0] * silu_fast(bflo(zw)), ov[1] * rstd * nw[1] * silu_fast(bfhi(zw))); } }
}

#ifndef ONE_LAUNCH
#define ONE_LAUNCH 1
#endif

template <class Epi>
__device__ __forceinline__ void run_gemm(LAS unsigned char* lds, const bf16* A, const bf16* Bt, int m, int n, int k, const Epi& E) {
    pg8::Gemm g{A, Bt, m, n, k}; pg8::StaticOrder S; S.init(m, n, k, (int)gridDim.x, (int)blockIdx.x);
    pg8::gemm_phase<Epi, pg8::StaticOrder, true, true>(lds, g, S, E);
}

__device__ __forceinline__ void run_gemm_n2048(LAS unsigned char* lds, const bf16* A, const bf16* Bt, int k, bf16* Y, bf16* YS) {
    pg8::Gemm g{A, Bt, M, D, k};
    if (gridDim.x == 256) { pg8::TailSplitOrder S; S.init(D, k, 256, (int)blockIdx.x); pg8::gemm_phase<pg8::EpiY, pg8::TailSplitOrder, true, true>(lds, g, S, pg8::EpiY{Y, D, YS, (size_t)MS * D}); }
    else { pg8::StaticOrder S; S.init(M, D, k, (int)gridDim.x, (int)blockIdx.x); pg8::gemm_phase<pg8::EpiY, pg8::StaticOrder, true, true>(lds, g, S, pg8::EpiY{Y, D, YS, (size_t)MS * D}); }
}

__global__ void __launch_bounds__(512, 2) fwd_kernel(Args a) {
    extern __shared__ __attribute__((aligned(16))) unsigned char lds_raw[];
    LAS unsigned char* lds = (LAS unsigned char*)lds_raw;
    const int tid = threadIdx.x, lane = tid & 63, wave = __builtin_amdgcn_readfirstlane(tid >> 6);
    const int lo = a.ph_lo, hi = a.ph_hi;
#if ONE_LAUNCH
    volatile LAS unsigned* MISC = (volatile LAS unsigned*)(lds + MISC_OFF);
    if (tid < 4) MISC[tid] = 0u;
    __syncthreads();
    XcdBarrier bar = xcd_barrier_post((unsigned*)(a.ws + WS_CTL) + (size_t)a.li * 4096, MISC);
#define SEAMB() xcd_barrier(bar)
#else
#define SEAMB() do { } while (0)
#endif
#define IN(k) (lo <= (k) && (k) < hi)
#ifndef PROBE_F1
#define PROBE_F1 1
#endif
#ifndef PROBE_GS
#define PROBE_GS 1
#endif
#ifndef PROBE_MASK
#define PROBE_MASK 0u
#endif
#ifndef PROBE_XBAR
#define PROBE_XBAR 0
#endif
#define PH(k, ...) if (IN(k)) { __VA_ARGS__ if ((k) + 1 < hi) SEAMB(); if ((k) == 2) for (int xb_ = 0; xb_ < PROBE_XBAR; ++xb_) SEAMB(); }

#define xp (a.in[0])
#define xs (a.in[1])
#define npre (a.in[9])
#define npost (a.in[10])
#define Hb ((bf16*)(a.ws + WS_H))
#define Pb ((bf16*)(a.ws + WS_P))
#define AOb ((bf16*)(a.ws + WS_AO))
#define Yb ((bf16*)(a.ws + WS_Y))
#define XBb ((bf16*)(a.ws + WS_XB))
#define YSb ((bf16*)(a.ws + WS_YS))
#define YSsel (gridDim.x == 256 ? YSb : (bf16*)nullptr)
#define OBb ((bf16*)(a.ws + WS_OB))
#define MODb ((float*)(a.ws + WS_MOD))
#define ABb ((float*)(a.ws + WS_AB))
#define GLb ((float*)(a.ws + WS_GL))
#define ROTb ((const f32x2*)(a.ws + WS_ROT))

    PH(0,  prep_phase(a, lds, tid, lane, wave);)

    PH(2,  thin_phase<true, false, true, false>(xp, xs, XBb, a.out, Yb, YSsel, MODb, npost, 0, 0.f, npre + 0 * D, 0 * LMOD + 0 * 6144, Hb, lds, tid, lane, wave);)
    PH(3,  run_gemm(lds, Hb, (const bf16*)(a.ws + WS_WGU + 0 * SZ_WGU), M, NGU, D, pg8::EpiSwiGLU{Pb, DFF});)
    PH(4,  run_gemm_n2048(lds, Pb, (const bf16*)(a.ws + WS_WDN + 0 * SZ_WDN), DFF, Yb, YSb);)
    PH(5,  thin_phase<true, true, true, false>(xp, xs, XBb, a.out, Yb, YSsel, MODb, npost + 0 * D, 0 * LMOD + 0 * 6144 + 4096, 0.5f, npre + 1 * D, 0 * LMOD + 1 * 6144, Hb, lds, tid, lane, wave);)
    PH(6,  run_gemm(lds, Hb, (const bf16*)(a.ws + WS_WRI), M, RIN, D, pg8::EpiBf16G{Pb, RIN, nullptr, -1});)
    PH(7,
        for (int it = blockIdx.x; it < 256; it += gridDim.x) ret_prompt_item(it, Pb, ROTb, OBb, a.out + O_RETP, lds, tid, lane, wave);
        for (int it = blockIdx.x; it < DB * 8; it += gridDim.x) ret_sample_item(it, Pb, ROTb, a.in[4], OBb, a.out + O_RETS, lds, tid, lane, wave);)
    PH(8,  ret_norm_phase(OBb, Pb, AOb, lane, wave);)
    PH(9,  run_gemm_n2048(lds, AOb, (const bf16*)(a.ws + WS_WRO), RV, Yb, YSb);)
    PH(10,  thin_phase<false, true, true, false>(xp, xs, XBb, a.out, Yb, YSsel, MODb, npost + 1 * D, 0 * LMOD + 1 * 6144 + 4096, 1.0f, npre + 2 * D, 0 * LMOD + 2 * 6144, Hb, lds, tid, lane, wave);)
    PH(11,  run_gemm(lds, Hb, (const bf16*)(a.ws + WS_WGU + 1 * SZ_WGU), M, NGU, D, pg8::EpiSwiGLU{Pb, DFF});)
    PH(12,  run_gemm_n2048(lds, Pb, (const bf16*)(a.ws + WS_WDN + 1 * SZ_WDN), DFF, Yb, YSb);)
    PH(13,  thin_phase<false, true, true, false>(xp, xs, XBb, a.out, Yb, YSsel, MODb, npost + 2 * D, 0 * LMOD + 2 * 6144 + 4096, 0.5f, npre + 3 * D, 1 * LMOD + 0 * 6144, Hb, lds, tid, lane, wave);)

    PH(14,  run_gemm(lds, Hb, (const bf16*)(a.ws + WS_WGU + 2 * SZ_WGU), M, NGU, D, pg8::EpiSwiGLU{Pb, DFF});)
    PH(15,  run_gemm_n2048(lds, Pb, (const bf16*)(a.ws + WS_WDN + 2 * SZ_WDN), DFF, Yb, YSb);)
    PH(16,  thin_phase<false, true, true, false>(xp, xs, XBb, a.out, Yb, YSsel, MODb, npost + 3 * D, 1 * LMOD + 0 * 6144 + 4096, 0.5f, npre + 4 * D, 1 * LMOD + 1 * 6144, Hb, lds, tid, lane, wave);)
    PH(17,  run_gemm(lds, Hb, (const bf16*)(a.ws + WS_WGI), M, GINP, D, pg8::EpiBf16G{Pb, GINP, ABb, 48});)
    PH(18,
        gdn_f1_block(Pb, ABb, a.in[16], a.in[17], a.in[18], a.ws + WS_F1, GLb, lds, tid, lane, wave);
        { const int gt = (int)blockIdx.x * 512 + tid, GT = (int)gridDim.x * 512;
          for (int i = gt; i < (NB + DB) * 3 * (CONVCH / 8); i += GT) { const int c8 = (i % (CONVCH / 8)) * 8, j = (i / (CONVCH / 8)) % 3, bb = i / (3 * (CONVCH / 8));
              const int row = bb < NB ? bb * SEQ + SEQ - 3 + j : MP + (bb - NB) * DSEQ + DSEQ - 3 + j;
              float v[8]; unpack8(*(const u32x4*)(Pb + (size_t)row * GINP + c8), v);
              float* op = a.out + O_CONVP + (size_t)(bb * 3 + j) * CONVCH + c8; *(f32x4*)op = (f32x4){v[0], v[1], v[2], v[3]}; *(f32x4*)(op + 4) = (f32x4){v[4], v[5], v[6], v[7]}; } })
    PH(19,  if (blockIdx.x < 128) gdn_f2_item((int)blockIdx.x, a.ws + WS_F1, GLb, Pb, a.in[19], AOb, a.out + O_GDNP, lds, tid, lane, wave);
            else { LAS float* wl = (LAS float*)(lds + wave * 16384);
                   for (int item = ((int)blockIdx.x - 128) * 8 + wave; item < 4096; item += 1024)
                       gdn_sample_wave(item, Pb, ABb, a.in[16], a.in[17], a.in[18], a.in[19], a.in[5], a.in[6], AOb, a.out + O_GDNS, wl, lane); })
    PH(20,  run_gemm_n2048(lds, AOb, (const bf16*)(a.ws + WS_WGO), RV, Yb, YSb);)
    PH(21,  thin_phase<false, true, true, false>(xp, xs, XBb, a.out, Yb, YSsel, MODb, npost + 4 * D, 1 * LMOD + 1 * 6144 + 4096, 1.0f, npre + 5 * D, 1 * LMOD + 2 * 6144, Hb, lds, tid, lane, wave);)
    PH(22,  run_gemm(lds, Hb, (const bf16*)(a.ws + WS_WGU + 3 * SZ_WGU), M, NGU, D, pg8::EpiSwiGLU{Pb, DFF});)
    PH(23,  run_gemm_n2048(lds, Pb, (const bf16*)(a.ws + WS_WDN + 3 * SZ_WDN), DFF, Yb, YSb);)
    PH(24, thin_phase<false, true, false, true>(xp, xs, XBb, a.out, Yb, YSsel, MODb, npost + 5 * D, 1 * LMOD + 2 * 6144 + 4096, 0.5f, npre, 0, Hb, lds, tid, lane, wave);)
#undef IN
#undef SEAMB
#undef PH
#undef xp
#undef xs
#undef npre
#undef npost
#undef Hb
#undef Pb
#undef AOb
#undef Yb
#undef XBb
#undef YSb
#undef YSsel
#undef OBb
#undef MODb
#undef ABb
#undef GLb
#undef ROTb
}

extern "C" void kernel_launch(void* const* d_in, const int* in_sizes, int n_in, void* d_out, int out_size, void* d_ws, size_t ws_size, hipStream_t stream) {
    static int grid = 0;
    if (grid == 0) {
        if (n_in != 21 || (size_t)out_size != O_END || ws_size < WS_END) { fprintf(stderr, "kernel_launch: unexpected problem: n_in %d out %d ws %zu (need %zu)\n", n_in, out_size, ws_size, (size_t)WS_END); grid = -1; return; }
        int dev = 0, cus = 0, per_cu = 0;
        if (hipGetDevice(&dev) != hipSuccess || hipDeviceGetAttribute(&cus, hipDeviceAttributeMultiprocessorCount, dev) != hipSuccess) { grid = -1; return; }
        if (hipFuncSetAttribute((const void*)fwd_kernel, hipFuncAttributeMaxDynamicSharedMemorySize, LDS_BYTES) != hipSuccess) { fprintf(stderr, "kernel_launch: hipFuncSetAttribute failed\n"); grid = -1; return; }
        if (hipOccupancyMaxActiveBlocksPerMultiprocessor(&per_cu, (const void*)fwd_kernel, 512, LDS_BYTES) != hipSuccess || per_cu < 1) { fprintf(stderr, "kernel_launch: occupancy query says %d blocks per CU\n", per_cu); }
        (void)hipGetLastError();
        if (cus < 256) { fprintf(stderr, "kernel_launch: built for a 256-CU device, found %d\n", cus); grid = -1; return; }
        grid = 256;
    }
    if (grid < 0) return;
    (void)hipMemsetAsync((char*)d_ws + WS_CTL, 0, CTL_BYTES, stream);
    Args a{};
    for (int i = 0; i < 21; ++i) a.in[i] = (const float*)d_in[i];
    a.out = (float*)d_out; a.ws = (unsigned char*)d_ws;
#if ONE_LAUNCH
    int lo = 0;
    for (int k = 0; k < NPH; ++k) if ((PROBE_MASK >> k) & 1u) { a.ph_lo = lo; a.ph_hi = k + 1; hipLaunchKernelGGL(fwd_kernel, dim3(grid), dim3(512), LDS_BYTES, stream, a); lo = k; ++a.li; }
    a.ph_lo = lo; a.ph_hi = NPH;
    hipLaunchKernelGGL(fwd_kernel, dim3(grid), dim3(512), LDS_BYTES, stream, a);
#else
    for (int k = 0; k < NPH; ++k) { a.ph_lo = k; a.ph_hi = k + 1; hipLaunchKernelGGL(fwd_kernel, dim3(grid), dim3(512), LDS_BYTES, stream, a); }
#endif
    const hipError_t le = hipPeekAtLastError();
    if (le != hipSuccess) fprintf(stderr, "kernel_launch: launch failed: %s\n", hipGetErrorName(le));
}
```

```cpp
#include <hip/hip_runtime.h>
#include <cstdio>
#include <cstdint>
#define ONE_LAUNCH 1
#define PROBE_MASK 0x0u
namespace pg8 {
#define PG8_LAS __attribute__((address_space(3)))
typedef unsigned short bf16_t;
typedef short bf16x8 __attribute__((ext_vector_type(8)));
typedef float f32x4 __attribute__((ext_vector_type(4)));
typedef unsigned u32x4 __attribute__((ext_vector_type(4)));
constexpr int BM = 256, BK = 64, HALF = 128, HTB = HALF * BK * 2  , STAGE_BYTES = 8 * HTB, NXCD = 8, WGM = 8;

__host__ __device__ __forceinline__ int lds_byte(int r, int c) { const int st = (r >> 4) * 2 + (c >> 5), rr = r & 15, cc = c & 31, ob = rr * 64 + cc * 2; return st * 1024 + (ob ^ (((ob >> 9) & 1) << 5)); }
__host__ __device__ __forceinline__ void stage_rc(int b, int& R, int& C) { const int st = b / 1024, sb = b % 1024, swz = sb ^ (((sb >> 9) & 1) << 5); R = (st >> 1) * 16 + swz / 64; C = (st & 1) * 32 + (swz % 64) / 2; }
__host__ __device__ __forceinline__ int perm32(int rho) { const int n = rho >> 4, i = rho & 15; return 8 * (i >> 2) + 4 * n + (i & 3); }

struct Unit { int pm, pn, k0, nt, ks; };
struct Gemm { const bf16_t* A; const bf16_t* Bt; int M, N, K; };

struct StaticOrder {
    int nM, nN, nwg, G, c, ntf;
    __host__ __device__ void init(int M, int N, int K, int G_, int c_) { nM = M / BM; nN = N / BM; nwg = nM * nN; G = G_; c = c_; ntf = K / BK; }
    __host__ __device__ bool next(int i, Unit& u) const {
        const long L = (long)i * G + c; if (L >= nwg) return false;
        int wgid = (int)L; { const int q = nwg / NXCD, r = nwg % NXCD, xcd = wgid % NXCD, off = wgid / NXCD; wgid = (xcd < r ? xcd * (q + 1) : r * (q + 1) + (xcd - r) * q) + off; }
        const int nig = WGM * nN, gid = wgid / nig, fm = gid * WGM, gsz = (nM - fm) < WGM ? (nM - fm) : WGM;
        u.pm = fm + ((wgid % nig) % gsz); u.pn = (wgid % nig) / gsz; u.k0 = 0; u.nt = ntf; u.ks = -1; return true;
    }
    __device__ __forceinline__ void a_ready(const Unit&) const {}
    __device__ __forceinline__ void done(const Unit&) const {}
};
typedef __bf16 bf16x2_t __attribute__((ext_vector_type(2)));
typedef float f32x2_t __attribute__((ext_vector_type(2)));
__device__ __forceinline__ unsigned cvt_pk_bf16(float lo, float hi) { const f32x2_t v = {lo, hi}; const bf16x2_t b = __builtin_convertvector(v, bf16x2_t); return __builtin_bit_cast(unsigned, b); }
typedef unsigned u32x2 __attribute__((ext_vector_type(2)));

struct EpiF32 {
    static constexpr bool PERM = false, AFTER_DRAIN = false;
    float* C; int ldc; const float* bias;
    __device__ __forceinline__ void operator()(const f32x4 (&acc)[2][2][4][2], const Unit& u, int wr, int wc, int fr, int fq) const {
        const int row0 = u.pm * BM + wr * 64 + fr, col0 = u.pn * BM + wc * 32 + 4 * fq;
        f32x4 bv[2][2];
#pragma unroll
        for (int bj = 0; bj < 2; ++bj)
#pragma unroll
            for (int n = 0; n < 2; ++n) bv[bj][n] = bias ? *(const f32x4*)(bias + col0 + bj * HALF + n * 16) : (f32x4){0.f, 0.f, 0.f, 0.f};
#pragma unroll
        for (int ai = 0; ai < 2; ++ai)
#pragma unroll
            for (int m = 0; m < 4; ++m) { float* rowp = C + (size_t)(row0 + ai * HALF + m * 16) * ldc + col0;
#pragma unroll
                for (int bj = 0; bj < 2; ++bj)
#pragma unroll
                    for (int n = 0; n < 2; ++n) *(f32x4*)(rowp + bj * HALF + n * 16) = acc[ai][bj][m][n] + bv[bj][n]; }
    }
};
struct EpiBf16G {
    static constexpr bool PERM = true, AFTER_DRAIN = false;
    bf16_t* O; int ldc; float* ab; int abtile;
    __device__ __forceinline__ void operator()(const f32x4 (&acc)[2][2][4][2], const Unit& u, int wr, int wc, int fr, int fq) const {
        const int row0 = u.pm * BM + wr * 64 + fr; const int col0 = u.pn * BM + wc * 32 + 8 * fq;
#pragma unroll
        for (int ai = 0; ai < 2; ++ai)
#pragma unroll
            for (int m = 0; m < 4; ++m) { bf16_t* rowp = O + (size_t)(row0 + ai * HALF + m * 16) * ldc + col0;
#pragma unroll
                for (int bj = 0; bj < 2; ++bj) { const f32x4 v0 = acc[ai][bj][m][0], v1 = acc[ai][bj][m][1];
                    u32x4 w; w.x = cvt_pk_bf16(v0[0], v0[1]); w.y = cvt_pk_bf16(v0[2], v0[3]); w.z = cvt_pk_bf16(v1[0], v1[1]); w.w = cvt_pk_bf16(v1[2], v1[3]);
                    *(u32x4*)(rowp + bj * HALF) = w; } }
        if (ab != nullptr && u.pn == abtile && wc < 2) {
#pragma unroll
            for (int ai = 0; ai < 2; ++ai)
#pragma unroll
                for (int m = 0; m < 4; ++m) { float* rp = ab + (size_t)(row0 + ai * HALF + m * 16) * 64 + wc * 32 + 8 * fq;
                    *(f32x4*)(rp) = acc[ai][0][m][0]; *(f32x4*)(rp + 4) = acc[ai][0][m][1]; }
        }
    }
};
struct EpiSwiGLU {
    static constexpr bool PERM = false, AFTER_DRAIN = false;
    bf16_t* O; int ldc;
    __device__ __forceinline__ void operator()(const f32x4 (&acc)[2][2][4][2], const Unit& u, int wr, int wc, int fr, int fq) const {
        const int row0 = u.pm * BM + wr * 64 + fr; const int col0 = u.pn * HALF + wc * 32 + 8 * fq;
#pragma unroll
        for (int ai = 0; ai < 2; ++ai)
#pragma unroll
            for (int m = 0; m < 4; ++m) { bf16_t* rowp = O + (size_t)(row0 + ai * HALF + m * 16) * ldc + col0; float r[8];
#pragma unroll
                for (int bj = 0; bj < 2; ++bj) { const f32x4 g = acc[ai][bj][m][0], up = acc[ai][bj][m][1];
#pragma unroll
                    for (int j = 0; j < 4; ++j) r[4 * bj + j] = g[j] * __builtin_amdgcn_rcpf(1.0f + __expf(-g[j])) * up[j]; }
                u32x4 w; w.x = cvt_pk_bf16(r[0], r[1]); w.y = cvt_pk_bf16(r[2], r[3]); w.z = cvt_pk_bf16(r[4], r[5]); w.w = cvt_pk_bf16(r[6], r[7]);
                *(u32x4*)rowp = w; }
    }
};
struct TailSplitOrder {
    StaticOrder S0; int q, P;
    __host__ __device__ void init(int N, int K, int G, int c) { S0.init(32 * BM, N, K, G, c); q = (c % NXCD) * (G / NXCD) + c / NXCD; P = K / 128; }
    __host__ __device__ bool next(int i, Unit& u) const {
        if (i == 0) return S0.next(0, u);
        if (i == 1) { const int x = q >> 5, l = q & 31, j = l & 7, t = l >> 3; u.pm = 32 + 2 * (x >> 2) + (t >> 1); u.pn = 2 * (x & 3) + (t & 1); const int p0 = (P * j) >> 3, p1 = (P * (j + 1)) >> 3; u.k0 = p0 * 128; u.nt = (p1 - p0) * 2; u.ks = j; return true; }
        return false;
    }
    __device__ __forceinline__ void a_ready(const Unit&) const {}
    __device__ __forceinline__ void done(const Unit&) const {}
};
struct EpiY {
    static constexpr bool PERM = true, AFTER_DRAIN = false;
    bf16_t* Y; int ldc; bf16_t* S; size_t slab_stride;
    __device__ __forceinline__ void operator()(const f32x4 (&acc)[2][2][4][2], const Unit& u, int wr, int wc, int fr, int fq) const {
        const int col0 = u.pn * BM + wc * 32 + 8 * fq; const bool tail = u.ks >= 0;
        bf16_t* base = tail ? S + (size_t)u.ks * slab_stride : Y;
        const int row0 = (tail ? u.pm - 32 : u.pm) * BM + wr * 64 + fr;
#pragma unroll
        for (int ai = 0; ai < 2; ++ai)
#pragma unroll
            for (int m = 0; m < 4; ++m) { bf16_t* rowp = base + (size_t)(row0 + ai * HALF + m * 16) * ldc + col0;
#pragma unroll
                for (int bj = 0; bj < 2; ++bj) { const f32x4 v0 = acc[ai][bj][m][0], v1 = acc[ai][bj][m][1];
                    u32x4 w; w.x = cvt_pk_bf16(v0[0], v0[1]); w.y = cvt_pk_bf16(v0[2], v0[3]); w.z = cvt_pk_bf16(v1[0], v1[1]); w.w = cvt_pk_bf16(v1[2], v1[3]);
                    *(u32x4*)(rowp + bj * HALF) = w; } }
    }
};

struct GuSplitOrder {
    StaticOrder S0; int c;
    __host__ __device__ void init(int M, int N, int K, int G, int c_) { S0.init(M, N, K, G, c_); c = c_; }
    __host__ __device__ bool next(int i, Unit& u) const {
        if (i < 6) return S0.next(i, u);
        if (i == 6 && c < 240) { StaticOrder T = S0; T.c = c / 5; if (!T.next(6, u)) return false; const int j = c % 5, p0 = (16 * j) / 5, p1 = (16 * (j + 1)) / 5; u.k0 = p0 * 128; u.nt = (p1 - p0) * 2; u.ks = j; return true; }
        return false;
    }
    __device__ __forceinline__ void a_ready(const Unit&) const {}
    __device__ __forceinline__ void done(const Unit&) const {}
};
struct EpiSwiGLUSplit {
    static constexpr bool PERM = false, AFTER_DRAIN = false;
    bf16_t* O; int ldc; bf16_t* SL;
    __device__ __forceinline__ void operator()(const f32x4 (&acc)[2][2][4][2], const Unit& u, int wr, int wc, int fr, int fq) const {
        if (u.ks < 0) {
            const int row0 = u.pm * BM + wr * 64 + fr; const int col0 = u.pn * HALF + wc * 32 + 8 * fq;
#pragma unroll
            for (int ai = 0; ai < 2; ++ai)
#pragma unroll
                for (int m = 0; m < 4; ++m) { bf16_t* rowp = O + (size_t)(row0 + ai * HALF + m * 16) * ldc + col0; float r[8];
#pragma unroll
                    for (int bj = 0; bj < 2; ++bj) { const f32x4 g = acc[ai][bj][m][0], up = acc[ai][bj][m][1];
#pragma unroll
                        for (int j = 0; j < 4; ++j) r[4 * bj + j] = g[j] * __builtin_amdgcn_rcpf(1.0f + __expf(-g[j])) * up[j]; }
                    u32x4 w; w.x = cvt_pk_bf16(r[0], r[1]); w.y = cvt_pk_bf16(r[2], r[3]); w.z = cvt_pk_bf16(r[4], r[5]); w.w = cvt_pk_bf16(r[6], r[7]);
                    *(u32x4*)rowp = w; }
        } else {
            bf16_t* gp = SL + ((size_t)((int)blockIdx.x / 5) * 5 + u.ks) * (2 * 256 * 128); bf16_t* up_ = gp + 256 * 128;
            const int col0 = wc * 32 + 8 * fq;
#pragma unroll
            for (int ai = 0; ai < 2; ++ai)
#pragma unroll
                for (int m = 0; m < 4; ++m) { const int rl = ai * HALF + wr * 64 + m * 16 + fr;
                    const f32x4 g0 = acc[ai][0][m][0], g1 = acc[ai][1][m][0], u0 = acc[ai][0][m][1], u1 = acc[ai][1][m][1];
                    u32x4 w; w.x = cvt_pk_bf16(g0[0], g0[1]); w.y = cvt_pk_bf16(g0[2], g0[3]); w.z = cvt_pk_bf16(g1[0], g1[1]); w.w = cvt_pk_bf16(g1[2], g1[3]); *(u32x4*)(gp + rl * 128 + col0) = w;
                    w.x = cvt_pk_bf16(u0[0], u0[1]); w.y = cvt_pk_bf16(u0[2], u0[3]); w.z = cvt_pk_bf16(u1[0], u1[1]); w.w = cvt_pk_bf16(u1[2], u1[3]); *(u32x4*)(up_ + rl * 128 + col0) = w; }
        }
    }
};
template <class Epi, class Sched, bool ALIGN_EPI = false, bool SP2 = false>
__device__ __forceinline__ void gemm_phase(PG8_LAS unsigned char* lds, const Gemm g, const Sched& S, const Epi& E) {
    const int tid = threadIdx.x, wid = __builtin_amdgcn_readfirstlane(tid >> 6), lane = tid & 63, wr = wid >> 2, wc = wid & 3, fr = lane & 15, fq = lane >> 4;
    const int K = g.K;
    unsigned voffA[2], voffB[2];
#pragma unroll
    for (int i = 0; i < 2; ++i) { int R, C; stage_rc(tid * 16 + i * 8192, R, C); const int Rb = Epi::PERM ? ((R & ~31) + perm32(R & 31)) : R;
        voffA[i] = (unsigned)(R * K + C) * 2u; voffB[i] = (unsigned)(Rb * K + C) * 2u; }
    const size_t kstep = (size_t)(BK * 2);
    const size_t hstep = (size_t)HALF * K * 2;
    const size_t tstep = 2 * hstep;
    const unsigned ldsw = (unsigned)wid * 1024u;
    const int aoff = lds_byte(wr * 64 + fr, fq * 8), boff = lds_byte(wc * 32 + fr, fq * 8);
#define PG8_SA(b, h) (((b) * 2 + (h)) * HTB)
#define PG8_SB(b, h) ((4 + (b) * 2 + (h)) * HTB)
#define PG8_STAGE(bufoff, gbase, voff) do { _Pragma("unroll") for (int _i = 0; _i < 2; ++_i) \
        __builtin_amdgcn_global_load_lds((const unsigned*)((const char*)(gbase) + (voff)[_i]), (PG8_LAS unsigned*)(lds + (bufoff) + ldsw + _i * 8192), 16, 0, 0); } while (0)
#define PG8_LDA(dst, b, h) do { _Pragma("unroll") for (int m = 0; m < 4; ++m) _Pragma("unroll") for (int k = 0; k < 2; ++k) dst[m][k] = *(const PG8_LAS bf16x8*)(lds + PG8_SA(b, h) + aoff + m * 2048 + k * 1024); } while (0)
#define PG8_LDB(dst, b, h) do { _Pragma("unroll") for (int n = 0; n < 2; ++n) _Pragma("unroll") for (int k = 0; k < 2; ++k) dst[n][k] = *(const PG8_LAS bf16x8*)(lds + PG8_SB(b, h) + boff + n * 2048 + k * 1024); } while (0)
#define PG8_MMA(ai, bj, At, Bt) do { __builtin_amdgcn_s_setprio(1); _Pragma("unroll") for (int m = 0; m < 4; ++m) _Pragma("unroll") for (int n = 0; n < 2; ++n) _Pragma("unroll") for (int k = 0; k < 2; ++k) \
        acc[ai][bj][m][n] = __builtin_amdgcn_mfma_f32_16x16x32_bf16(Bt[n][k], At[m][k], acc[ai][bj][m][n], 0, 0, 0); __builtin_amdgcn_s_setprio(0); } while (0)
#define PG8_WAIT_V(n) asm volatile("s_waitcnt vmcnt(" #n ")" ::: "memory")
#define PG8_WAIT_L(n) asm volatile("s_waitcnt lgkmcnt(" #n ")" ::: "memory")
#define PG8_BAR __builtin_amdgcn_s_barrier()
#define PG8_SCHED __builtin_amdgcn_sched_barrier(0)
    Unit cur, nxt; int ui = 0;
    if (!S.next(0, cur)) return;
    f32x4 acc[2][2][4][2];
#pragma unroll
    for (int a = 0; a < 2; ++a)
#pragma unroll
        for (int b = 0; b < 2; ++b)
#pragma unroll
            for (int m = 0; m < 4; ++m)
#pragma unroll
                for (int n = 0; n < 2; ++n) acc[a][b][m][n] = (f32x4){0.f, 0.f, 0.f, 0.f};
    bf16x8 At[4][2], B0[2][2], B1[2][2];
    const char* cA = (const char*)g.A + (size_t)cur.pm * tstep + (size_t)cur.k0 * 2; const char* cB = (const char*)g.Bt + (size_t)cur.pn * tstep + (size_t)cur.k0 * 2;
    S.a_ready(cur);
    if constexpr (SP2) {
        PG8_STAGE(PG8_SB(0, 0), cB, voffB); PG8_STAGE(PG8_SB(0, 1), cB + hstep, voffB); PG8_STAGE(PG8_SA(0, 0), cA, voffA); PG8_STAGE(PG8_SA(0, 1), cA + hstep, voffA);
        if (wr == 1) PG8_BAR;
        PG8_WAIT_V(2); PG8_BAR;
        PG8_STAGE(PG8_SB(1, 0), cB + kstep, voffB); PG8_STAGE(PG8_SA(1, 0), cA + kstep, voffA); PG8_STAGE(PG8_SB(1, 1), cB + hstep + kstep, voffB);
        PG8_WAIT_V(6); PG8_BAR;
    } else {
        PG8_STAGE(PG8_SB(0, 0), cB, voffB); PG8_STAGE(PG8_SA(0, 0), cA, voffA); PG8_STAGE(PG8_SB(0, 1), cB + hstep, voffB); PG8_STAGE(PG8_SA(0, 1), cA + hstep, voffA);
        if (wr == 1) PG8_BAR;
        PG8_WAIT_V(4); PG8_BAR;
        PG8_STAGE(PG8_SB(1, 0), cB + kstep, voffB); PG8_STAGE(PG8_SA(1, 0), cA + kstep, voffA); PG8_STAGE(PG8_SB(1, 1), cB + hstep + kstep, voffB);
        PG8_WAIT_V(6); PG8_BAR;
    }
    for (;;) {
        const bool has_next = S.next(ui + 1, nxt);
        const char* nA = has_next ? (const char*)g.A + (size_t)nxt.pm * tstep + (size_t)nxt.k0 * 2 : cA; const char* nB = has_next ? (const char*)g.Bt + (size_t)nxt.pn * tstep + (size_t)nxt.k0 * 2 : cB;
        const int nt = cur.nt;
        for (int t = 0; t < nt; t += 2) {
            const bool last = (t == nt - 2);
            const char* a1 = cA + (size_t)(t + 1) * kstep;
            const char* a2 = last ? nA : cA + (size_t)(t + 2) * kstep; const char* b2 = last ? nB : cB + (size_t)(t + 2) * kstep;
            const char* a3 = a2 + kstep; const char* b3 = b2 + kstep;
            if (last && has_next) S.a_ready(nxt);
            if constexpr (SP2) {
            PG8_LDB(B0, 0, 0); PG8_LDB(B1, 0, 1); PG8_SCHED; PG8_LDA(At, 0, 0); PG8_STAGE(PG8_SA(1, 1), a1 + hstep, voffA);
            PG8_WAIT_V(8); PG8_WAIT_L(0); PG8_BAR; PG8_MMA(0, 0, At, B0); PG8_MMA(0, 1, At, B1); PG8_BAR; PG8_SCHED;
            PG8_LDA(At, 0, 1); PG8_STAGE(PG8_SB(0, 0), b2, voffB); PG8_STAGE(PG8_SB(0, 1), b2 + hstep, voffB); PG8_STAGE(PG8_SA(0, 0), a2, voffA);
            PG8_WAIT_V(8); PG8_WAIT_L(0); PG8_BAR; PG8_MMA(1, 0, At, B0); PG8_MMA(1, 1, At, B1); PG8_BAR; PG8_SCHED;
            PG8_LDB(B0, 1, 0); PG8_LDB(B1, 1, 1); PG8_SCHED; PG8_LDA(At, 1, 0); PG8_STAGE(PG8_SA(0, 1), a2 + hstep, voffA);
            PG8_WAIT_V(8); PG8_WAIT_L(0); PG8_BAR; PG8_MMA(0, 0, At, B0); PG8_MMA(0, 1, At, B1); PG8_BAR; PG8_SCHED;
            PG8_LDA(At, 1, 1); PG8_STAGE(PG8_SB(1, 0), b3, voffB); PG8_STAGE(PG8_SB(1, 1), b3 + hstep, voffB); PG8_STAGE(PG8_SA(1, 0), a3, voffA);
            PG8_WAIT_V(8); PG8_WAIT_L(0); PG8_BAR; PG8_MMA(1, 0, At, B0); PG8_MMA(1, 1, At, B1); PG8_BAR; PG8_SCHED;
            } else {
            PG8_LDB(B0, 0, 0); PG8_SCHED; PG8_LDA(At, 0, 0); PG8_STAGE(PG8_SA(1, 1), a1 + hstep, voffA);
            PG8_WAIT_L(8); PG8_BAR; PG8_WAIT_L(0); PG8_MMA(0, 0, At, B0); PG8_BAR; PG8_SCHED;
            PG8_LDB(B1, 0, 1); PG8_STAGE(PG8_SB(0, 0), b2, voffB);
            PG8_BAR; PG8_WAIT_L(0); PG8_MMA(0, 1, At, B1); PG8_BAR;
            PG8_LDA(At, 0, 1); PG8_STAGE(PG8_SA(0, 0), a2, voffA);
            PG8_BAR; PG8_WAIT_L(0); PG8_MMA(1, 0, At, B0); PG8_BAR; PG8_SCHED;
            PG8_STAGE(PG8_SB(0, 1), b2 + hstep, voffB);
            PG8_WAIT_V(6); PG8_BAR; PG8_MMA(1, 1, At, B1); PG8_BAR;
            PG8_LDB(B0, 1, 0); PG8_SCHED; PG8_LDA(At, 1, 0); PG8_STAGE(PG8_SA(0, 1), a2 + hstep, voffA);
            PG8_WAIT_L(8); PG8_BAR; PG8_WAIT_L(0); PG8_MMA(0, 0, At, B0); PG8_BAR; PG8_SCHED;
            PG8_LDB(B1, 1, 1); PG8_STAGE(PG8_SB(1, 0), b3, voffB);
            PG8_BAR; PG8_WAIT_L(0); PG8_MMA(0, 1, At, B1); PG8_BAR;
            PG8_LDA(At, 1, 1); PG8_STAGE(PG8_SA(1, 0), a3, voffA);
            PG8_BAR; PG8_WAIT_L(0); PG8_MMA(1, 0, At, B0); PG8_BAR; PG8_SCHED;
            PG8_STAGE(PG8_SB(1, 1), b3 + hstep, voffB);
            PG8_WAIT_V(6); PG8_BAR; PG8_MMA(1, 1, At, B1); PG8_BAR;
            }
        }
        if constexpr (ALIGN_EPI) { if (wr == 0) PG8_BAR; }
        if constexpr (!Epi::AFTER_DRAIN) { E(acc, cur, wr, wc, fr, fq); S.done(cur); }
        if (!has_next) break;
#pragma unroll
        for (int a = 0; a < 2; ++a)
#pragma unroll
            for (int b = 0; b < 2; ++b)
#pragma unroll
                for (int m = 0; m < 4; ++m)
#pragma unroll
                    for (int n = 0; n < 2; ++n) acc[a][b][m][n] = (f32x4){0.f, 0.f, 0.f, 0.f};
        cur = nxt; cA = nA; cB = nB; ++ui;
        if constexpr (ALIGN_EPI) { if (wr == 1) PG8_BAR; }
    }
    PG8_WAIT_V(0);
    if constexpr (!ALIGN_EPI) { if (wr == 0) PG8_BAR; }
    PG8_BAR;
    if constexpr (Epi::AFTER_DRAIN) { E.fused(acc, cur, wr, wc, fr, fq, lds, wid, lane); S.done(cur); }
#undef PG8_SA
#undef PG8_SB
#undef PG8_STAGE
#undef PG8_LDA
#undef PG8_LDB
#undef PG8_MMA
#undef PG8_WAIT_V
#undef PG8_WAIT_L
#undef PG8_BAR
#undef PG8_SCHED
}
}
#define XB_TMO      128
#define XB_XCNT(j)  (256  + 64 * (j))
#define XB_XSUB(j)  (1280 + 64 * (j))
#define XB_XGEN(j)  (2304 + 64 * (j))
#define XB_TOP      3328
#define XB_TOPGEN   3392
#define XCD_BAR_WORDS 3456
#define XB_SPIN_CAP (1u << 18)
#define LAS __attribute__((address_space(3)))

__device__ __forceinline__ unsigned xb_ld(unsigned* p)              { return __hip_atomic_load(p, __ATOMIC_RELAXED, __HIP_MEMORY_SCOPE_AGENT); }
__device__ __forceinline__ unsigned xb_add(unsigned* p, unsigned v) { return __hip_atomic_fetch_add(p, v, __ATOMIC_RELAXED, __HIP_MEMORY_SCOPE_AGENT); }
__device__ __forceinline__ unsigned xb_xcc_id() { return (unsigned)__builtin_amdgcn_s_getreg((3 << 11) | 20) & 0xFu; }
#define XB_SPIN(cond, bar) do { unsigned _sp = 0; while (cond) { __builtin_amdgcn_s_sleep(1); \
    if ((++_sp & 255u) == 0u) { if (xb_ld(&(bar)[XB_TMO])) break; if (_sp > XB_SPIN_CAP) { atomicAdd(&(bar)[XB_TMO], 1u); break; } } } } while (0)

struct XcdBarrier {
    unsigned* bar; unsigned x;
    volatile LAS unsigned* st;
};

__device__ __forceinline__ XcdBarrier xcd_barrier_post(unsigned* bar, volatile LAS unsigned* st) {
    XcdBarrier b; b.bar = bar; b.x = xb_xcc_id(); b.st = st;
    if (threadIdx.x == 0) (void)xb_add(&bar[XB_XCNT(b.x)], 1u);
    return b;
}
__device__ __forceinline__ void xcd_barrier_complete(unsigned* bar, unsigned x, unsigned& nloc, unsigned& nx) {
    const unsigned G = gridDim.x * gridDim.y * gridDim.z;
    unsigned sum, cnt, mine, sp = 0u;
    for (;;) {
        sum = 0u; cnt = 0u; mine = 0u;
#pragma unroll
        for (unsigned j = 0; j < 16; ++j) { const unsigned c = xb_ld(&bar[XB_XCNT(j)]); sum += c; cnt += (c > 0u) ? 1u : 0u; mine = (j == x) ? c : mine; }
        if (sum == G) break;
        __builtin_amdgcn_s_sleep(1);
        if ((++sp & 255u) == 0u) { if (xb_ld(&bar[XB_TMO])) break; if (sp > XB_SPIN_CAP) { atomicAdd(&bar[XB_TMO], 1u); break; } }
    }
    nloc = mine > 0u ? mine : 1u; nx = cnt > 0u ? cnt : 1u;
}

__device__ __forceinline__ void xcd_barrier(const XcdBarrier& b) {
    asm volatile("s_waitcnt vmcnt(0)" ::: "memory");
    __syncthreads();
    if (threadIdx.x == 0) {
        unsigned* bar = b.bar;
        __builtin_amdgcn_s_waitcnt(0);
        unsigned nloc = b.st[0], nx = b.st[1];
        if (nloc == 0u) { xcd_barrier_complete(bar, b.x, nloc, nx); b.st[0] = nloc; b.st[1] = nx; }
        const unsigned old = xb_add(&bar[XB_XSUB(b.x)], 1u);
        const unsigned gen = old / nloc;
        if (old + 1u == (gen + 1u) * nloc) {
            __builtin_amdgcn_fence(__ATOMIC_RELEASE, "agent");
            asm volatile("s_waitcnt vmcnt(0)" ::: "memory");
            const unsigned og = xb_add(&bar[XB_TOP], 1u);
            const unsigned tg = og / nx;
            if (og + 1u == (tg + 1u) * nx) xb_add(&bar[XB_TOPGEN], 1u);
            else XB_SPIN(xb_ld(&bar[XB_TOPGEN]) == tg, bar);
            __builtin_amdgcn_fence(__ATOMIC_ACQUIRE, "agent");
            xb_add(&bar[XB_XGEN(b.x)], 1u);
            asm volatile("s_waitcnt vmcnt(0)" ::: "memory");
        } else {
            XB_SPIN(xb_ld(&bar[XB_XGEN(b.x)]) == gen, bar);
            __builtin_amdgcn_fence(__ATOMIC_ACQUIRE, "agent");
            asm volatile("s_waitcnt vmcnt(0)" ::: "memory");
        }
    }
    __syncthreads();
}


typedef unsigned short bf16;
typedef short bf16x8 __attribute__((ext_vector_type(8)));
typedef float f32x4 __attribute__((ext_vector_type(4)));
typedef float f32x2 __attribute__((ext_vector_type(2)));
typedef unsigned u32x4 __attribute__((ext_vector_type(4)));
typedef unsigned u32x2 __attribute__((ext_vector_type(2)));

constexpr int D = 2048, MP = 8192, MS = 1024, M = MP + MS, DFF = 5632, NGU = 2 * DFF;
constexpr int SEQ = 2048, NB = 4, DB = 128, DSEQ = 8, PAST = 16384;
constexpr int RIN = 12288, RV = 4096;
constexpr int GIN = 12352, GINP = 12544;
constexpr int NMOD = 36864, LMOD = 18432, MODROWS = 256, NMB = 132;
constexpr int CONVCH = 8192;
constexpr float EPS = 1e-6f;
constexpr int NPH = 25;

constexpr size_t O_Y = 0, O_RETP = (size_t)M * D, O_RETS = O_RETP + (size_t)NB * 8 * 256 * 512, O_GDNP = O_RETS + (size_t)DB * 8 * 256 * 512,
                 O_GDNS = O_GDNP + (size_t)NB * 32 * 128 * 128, O_CONVP = O_GDNS + (size_t)DB * 32 * 128 * 128, O_CONVS = O_CONVP + (size_t)NB * 3 * CONVCH,
                 O_END = O_CONVS + (size_t)DB * 3 * CONVCH;

constexpr size_t MiB = 1u << 20;
constexpr size_t al(size_t x) { return (x + MiB - 1) / MiB * MiB; }
constexpr size_t WS_CTL = 0, CTL_BYTES = MiB;
constexpr size_t WS_WADA = WS_CTL + CTL_BYTES;
constexpr size_t WS_WGU = WS_WADA + al((size_t)NMOD * D * 2);
constexpr size_t SZ_WGU = (size_t)NGU * D * 2;
constexpr size_t WS_WDN = WS_WGU + al(4 * SZ_WGU);
constexpr size_t SZ_WDN = (size_t)D * DFF * 2;
constexpr size_t WS_WRI = WS_WDN + al(4 * SZ_WDN);
constexpr size_t WS_WRO = WS_WRI + al((size_t)RIN * D * 2);
constexpr size_t WS_WGI = WS_WRO + al((size_t)D * RV * 2);
constexpr size_t WS_WGO = WS_WGI + al((size_t)GINP * D * 2);
constexpr size_t WS_CS = WS_WGO + al((size_t)D * RV * 2);
constexpr size_t WS_MOD = WS_CS + al((size_t)MODROWS * D * 2);
constexpr size_t WS_ROT = WS_MOD + al((size_t)MODROWS * NMOD * 4);
constexpr size_t WS_H = WS_ROT + al((size_t)2056 * 128 * 8);
constexpr size_t WS_P = WS_H + al((size_t)M * D * 2);
constexpr size_t WS_Y = WS_P + al((size_t)M * GINP * 2);
constexpr size_t WS_XB = WS_Y + al((size_t)M * D * 4);
constexpr size_t WS_YS = WS_XB + al((size_t)M * D * 2);
constexpr size_t WS_OB = WS_YS + al((size_t)8 * MS * D * 4);
constexpr size_t WS_AO = WS_OB + al((size_t)M * RV * 4);
constexpr size_t WS_AB = WS_AO + al((size_t)M * RV * 2);
constexpr size_t WS_GL = WS_AB + al((size_t)M * 64 * 4);
constexpr size_t WS_F1 = WS_GL + MiB;
constexpr size_t F1_ITEM = 73728, F1_QG = 0, F1_W = 16384, F1_UT = 32768, F1_KDT = 49152, F1_ATT = 65536;
constexpr size_t WS_GS = WS_F1 + al(4096 * F1_ITEM);
constexpr size_t WS_END = WS_GS + al((size_t)240 * 2 * 256 * 128 * 2);

constexpr int LDS_BYTES = 160 * 1024;
constexpr int MISC_OFF = LDS_BYTES - 256;

__device__ __forceinline__ unsigned pk2(float lo, float hi) { return pg8::cvt_pk_bf16(lo, hi); }
__device__ __forceinline__ bf16 f2bf(float f) { return (bf16)(pk2(f, 0.f) & 0xffffu); }
__device__ __forceinline__ float bflo(unsigned w) { return __uint_as_float(w << 16); }
__device__ __forceinline__ float bfhi(unsigned w) { return __uint_as_float(w & 0xffff0000u); }
__device__ __forceinline__ float bf2f(bf16 b) { return __uint_as_float(((unsigned)b) << 16); }
__device__ __forceinline__ void unpack8(const u32x4 w, float (&f)[8]) { f[0] = bflo(w.x); f[1] = bfhi(w.x); f[2] = bflo(w.y); f[3] = bfhi(w.y); f[4] = bflo(w.z); f[5] = bfhi(w.z); f[6] = bflo(w.w); f[7] = bfhi(w.w); }
__device__ __forceinline__ u32x4 pack8(const float (&f)[8]) { u32x4 w; w.x = pk2(f[0], f[1]); w.y = pk2(f[2], f[3]); w.z = pk2(f[4], f[5]); w.w = pk2(f[6], f[7]); return w; }
#define LDS_BARRIER() do { asm volatile("s_waitcnt lgkmcnt(0)" ::: "memory"); __builtin_amdgcn_s_barrier(); asm volatile("" ::: "memory"); } while (0)
__device__ __forceinline__ float wave_sum(float v) {
#pragma unroll
    for (int o = 1; o < 64; o <<= 1) v += __shfl_xor(v, o);
    return v;
}
__device__ __forceinline__ float silu_f(float x) { return x / (1.0f + __expf(-x)); }
__device__ __forceinline__ float silu_fast(float x) { return x * __builtin_amdgcn_rcpf(1.0f + __expf(-x)); }
__device__ __forceinline__ float sigmoid_f(float x) { return 1.0f / (1.0f + __expf(-x)); }
__device__ __forceinline__ float softplus_f(float x) { return fmaxf(x, 0.f) + log1pf(__expf(-fabsf(x))); }

template <int K>
__device__ __forceinline__ void mma_tile(f32x4& acc, const LAS bf16* X, int ldx, const LAS bf16* Y, int ldy, int lane) {
    const int r = lane & 15, kq = lane >> 4;
    const LAS bf16* xp = X + r * ldx + kq * 8;
    const LAS bf16* yp = Y + r * ldy + kq * 8;
#pragma unroll
    for (int k = 0; k < K; k += 32) {
        const bf16x8 a = *(const LAS bf16x8*)(xp + k);
        const bf16x8 b = *(const LAS bf16x8*)(yp + k);
        acc = __builtin_amdgcn_mfma_f32_16x16x32_bf16(a, b, acc, 0, 0, 0);
    }
}

typedef short s16x4 __attribute__((ext_vector_type(4)));
__device__ __forceinline__ bf16x8 frag_tr(const LAS bf16* Mk, int ld, int lane) {
    const int g = lane >> 4, t = lane & 15, q = t >> 2, p = t & 3;
    const LAS bf16* a = Mk + (8 * g + q) * ld + 4 * p;
    const s16x4 lo = __builtin_amdgcn_ds_read_tr16_b64_v4i16((LAS s16x4*)a);
    const s16x4 hi = __builtin_amdgcn_ds_read_tr16_b64_v4i16((LAS s16x4*)(a + 4 * ld));
    return (bf16x8){lo[0], lo[1], lo[2], lo[3], hi[0], hi[1], hi[2], hi[3]};
}
__device__ __forceinline__ bf16x8 frag_n(const LAS bf16* T, int ld, int k0, int lane) { return *(const LAS bf16x8*)(T + (lane & 15) * ld + (lane >> 4) * 8 + k0); }
#define MFMA16(a, b, c) __builtin_amdgcn_mfma_f32_16x16x32_bf16((a), (b), (c), 0, 0, 0)
template <int K, bool XT, bool YT>
__device__ __forceinline__ void mma_tile2(f32x4& acc, const LAS bf16* X, int ldx, const LAS bf16* Y, int ldy, int lane) {
    const int r = lane & 15, kq = lane >> 4;
#pragma unroll
    for (int k = 0; k < K; k += 32) {
        const bf16x8 a = XT ? frag_tr(X + k * ldx, ldx, lane) : *(const LAS bf16x8*)(X + r * ldx + kq * 8 + k);
        const bf16x8 b = YT ? frag_tr(Y + k * ldy, ldy, lane) : *(const LAS bf16x8*)(Y + r * ldy + kq * 8 + k);
        acc = __builtin_amdgcn_mfma_f32_16x16x32_bf16(a, b, acc, 0, 0, 0);
    }
}

__device__ __forceinline__ void sincos_d(double x, double& s, double& c) {
    const double k = rint(x * 0.63661977236758134308);
    double r = fma(-k, 1.57079632679489655800e+00, x);
    r = fma(-k, 6.12323399573676603587e-17, r);
    const double r2 = r * r;
    double ps = -1.0 / 1307674368000.0;
    ps = fma(ps, r2, 1.0 / 6227020800.0); ps = fma(ps, r2, -1.0 / 39916800.0); ps = fma(ps, r2, 1.0 / 362880.0); ps = fma(ps, r2, -1.0 / 5040.0);
    ps = fma(ps, r2, 1.0 / 120.0); ps = fma(ps, r2, -1.0 / 6.0); ps = fma(ps * r2, r, r);
    double pc = 1.0 / 20922789888000.0;
    pc = fma(pc, r2, -1.0 / 87178291200.0); pc = fma(pc, r2, 1.0 / 479001600.0); pc = fma(pc, r2, -1.0 / 3628800.0); pc = fma(pc, r2, 1.0 / 40320.0);
    pc = fma(pc, r2, -1.0 / 720.0); pc = fma(pc, r2, 1.0 / 24.0); pc = fma(pc, r2, -0.5); pc = fma(pc, r2, 1.0);
    const int q = ((int)k) & 3;
    s = (q == 0) ? ps : (q == 1) ? pc : (q == 2) ? -ps : -pc;
    c = (q == 0) ? pc : (q == 1) ? -ps : (q == 2) ? -pc : ps;
}

struct Args { const float* in[21]; float* out; unsigned char* ws; int ph_lo, ph_hi, li, pad; };

struct Fr {
    LAS unsigned char* lds;
    int tid, lane, wave;
    const float* const* in;
    float* out; unsigned char* ws;
};

template <int MODE>
__device__ __forceinline__ void transpose_item(const float* W, int K, int N, bf16* WT, int row_off, LAS float* scr, int item, int lane) {
    const int nblk = N / 32, kb = item / nblk, nb = item % nblk, k0 = 64 * kb, n0 = 32 * nb;
#pragma unroll 8
    for (int i = 0; i < 32; ++i) { const int kk = 2 * i + (lane >> 5); scr[kk * 33 + (lane & 31)] = W[(size_t)(k0 + kk) * N + n0 + (lane & 31)]; }
    asm volatile("s_waitcnt lgkmcnt(0)" ::: "memory");
    const int c = lane & 7;
#pragma unroll
    for (int j = 0; j < 4; ++j) { const int n = (lane >> 3) + 8 * j; const LAS float* s = scr + (8 * c) * 33 + n;
        u32x4 o; o.x = pk2(s[0 * 33], s[1 * 33]); o.y = pk2(s[2 * 33], s[3 * 33]); o.z = pk2(s[4 * 33], s[5 * 33]); o.w = pk2(s[6 * 33], s[7 * 33]);
        int gn = n0 + n, drow;
        if (MODE == 0) drow = row_off + gn;
        else { const int up = gn >= DFF ? 1 : 0; const int nn = gn - up * DFF;
               const int pn = nn >> 7, wc = (nn >> 5) & 3, fq = (nn >> 3) & 3, bj = (nn >> 2) & 1, j = nn & 3; drow = 256 * pn + 128 * bj + 32 * wc + 16 * up + 4 * fq + j; }
        *(u32x4*)(WT + (size_t)drow * K + k0 + 8 * c) = o; }
    asm volatile("s_waitcnt lgkmcnt(0)" ::: "memory");
}
template <int MODE>
__device__ __forceinline__ void transpose_all(const float* W, int K, int N, bf16* WT, int row_off, LAS float* scr, int gw, int NGW, int lane) {
    const int ni = (K / 64) * (N / 32);
    for (int it = gw; it < ni; it += NGW) transpose_item<MODE>(W, K, N, WT, row_off, scr, it, lane);
}

__device__ __forceinline__ void ada_phase(const float* cp, const float* csmp, const float* wada, const float* bada, float* mod, LAS unsigned char* lds, int tid, int lane, int wave) {
    const int n0 = blockIdx.x * 144, layer = n0 / LMOD, nl0 = n0 % LMOD;
    const float* W = wada + (size_t)layer * D * LMOD + nl0;
    constexpr int BUF = 144 * 136 * 2 + 128 * 152 * 2;
    for (int i = tid; i < 2 * 12 * 136 / 2; i += 512) { const int bsel = i / (12 * 136 / 2), o = i % (12 * 136 / 2); ((LAS unsigned*)(lds + bsel * BUF + 132 * 136 * 2))[o] = 0u; }
    f32x4 wr[9], ar[9];
    f32x4 acc[9], accx = (f32x4){0.f, 0.f, 0.f, 0.f}, accy = (f32x4){0.f, 0.f, 0.f, 0.f};
#pragma unroll
    for (int m = 0; m < 9; ++m) acc[m] = (f32x4){0.f, 0.f, 0.f, 0.f};
#define ADA_LOAD(kc) do { _Pragma("unroll") for (int i = 0; i < 9; ++i) { const int idx = tid + 512 * i, row = idx / 36, c4 = idx % 36; wr[i] = *(const f32x4*)(W + (size_t)((kc) * 128 + row) * LMOD + 4 * c4); } \
        _Pragma("unroll") for (int i = 0; i < 9; ++i) { const int idx = tid + 512 * i, m = idx >> 5, k4 = idx & 31; ar[i] = (f32x4){0.f, 0.f, 0.f, 0.f}; \
            if (idx < 132 * 32) ar[i] = *(const f32x4*)((m < NB ? cp + (size_t)m * D : csmp + (size_t)(m - NB) * D) + (kc) * 128 + 4 * k4); } } while (0)
    ADA_LOAD(0);
#pragma unroll 1
    for (int kc = 0; kc < 16; ++kc) {
        LAS bf16* Ac = (LAS bf16*)(lds + (kc & 1) * BUF); LAS bf16* Wc = Ac + 144 * 136;
#pragma unroll
        for (int i = 0; i < 9; ++i) { const int idx = tid + 512 * i, row = idx / 36, c4 = idx % 36; u32x2 w; w.x = pk2(wr[i][0], wr[i][1]); w.y = pk2(wr[i][2], wr[i][3]); *(LAS u32x2*)(Wc + row * 152 + 4 * c4) = w; }
#pragma unroll
        for (int i = 0; i < 9; ++i) { const int idx = tid + 512 * i, m = idx >> 5, k4 = idx & 31;
            if (idx < 132 * 32) { u32x2 w; w.x = pk2(silu_fast(ar[i][0]), silu_fast(ar[i][1])); w.y = pk2(silu_fast(ar[i][2]), silu_fast(ar[i][3])); *(LAS u32x2*)(Ac + m * 136 + 4 * k4) = w; } }
        if (kc + 1 < 16) ADA_LOAD(kc + 1);
        LDS_BARRIER();
#pragma unroll
        for (int m = 0; m < 9; ++m) mma_tile2<128, false, true>(acc[m], Ac + m * 16 * 136, 136, Wc + wave * 16, 152, lane);
        mma_tile2<128, false, true>(accx, Ac + wave * 16 * 136, 136, Wc + 8 * 16, 152, lane);
        if (wave == 0) mma_tile2<128, false, true>(accy, Ac + 8 * 16 * 136, 136, Wc + 8 * 16, 152, lane);
    }
#undef ADA_LOAD
    const int fr = lane & 15, fq = lane >> 4;
    { const int n = n0 + 16 * wave + fr; const float bv = bada[n];
#pragma unroll
      for (int m = 0; m < 9; ++m)
#pragma unroll
          for (int ii = 0; ii < 4; ++ii) { const int row = 16 * m + 4 * fq + ii; if (row < NMB) mod[(size_t)row * NMOD + n] = acc[m][ii] + bv; } }
    { const int n = n0 + 128 + fr; const float bv = bada[n];
#pragma unroll
      for (int ii = 0; ii < 4; ++ii) { const int row = 16 * wave + 4 * fq + ii; if (row < NMB) mod[(size_t)row * NMOD + n] = accx[ii] + bv; }
      if (wave == 0) {
#pragma unroll
          for (int ii = 0; ii < 4; ++ii) { const int row = 128 + 4 * fq + ii; if (row < NMB) mod[(size_t)row * NMOD + n] = accy[ii] + bv; } } }
    LDS_BARRIER();
}

__device__ __forceinline__ void prep_phase(const Args& a, LAS unsigned char* lds, int tid, int lane, int wave) {
    ada_phase(a.in[2], a.in[3], a.in[7], a.in[8], (float*)(a.ws + WS_MOD), lds, tid, lane, wave);
    LAS float* scr = (LAS float*)(lds + wave * 8448);
    const int gw = blockIdx.x * 8 + wave, NGW = gridDim.x * 8;
    unsigned char* ws = a.ws;
#pragma unroll 1
    for (int i = 0; i < 4; ++i) {
        transpose_all<1>(a.in[11] + (size_t)i * D * NGU, D, NGU, (bf16*)(ws + WS_WGU + i * SZ_WGU), 0, scr, gw, NGW, lane);
        transpose_all<0>(a.in[12] + (size_t)i * DFF * D, DFF, D, (bf16*)(ws + WS_WDN + i * SZ_WDN), 0, scr, gw, NGW, lane);
    }
    transpose_all<0>(a.in[13], D, RIN, (bf16*)(ws + WS_WRI), 0, scr, gw, NGW, lane);
    transpose_all<0>(a.in[14], RV, D, (bf16*)(ws + WS_WRO), 0, scr, gw, NGW, lane);
    transpose_all<0>(a.in[15], D, GIN, (bf16*)(ws + WS_WGI), 0, scr, gw, NGW, lane);
    transpose_all<0>(a.in[20], RV, D, (bf16*)(ws + WS_WGO), 0, scr, gw, NGW, lane);
    const size_t gt = (size_t)blockIdx.x * 512 + tid, GT = (size_t)gridDim.x * 512;
    { unsigned* z = (unsigned*)(ws + WS_WGI + (size_t)GIN * D * 2); const size_t nz = (size_t)(GINP - GIN) * D / 2; for (size_t i = gt; i < nz; i += GT) z[i] = 0u; }
    { f32x2* rot = (f32x2*)(ws + WS_ROT);
      for (size_t i = gt; i < (size_t)2056 * 128; i += GT) { const int p = (int)(i >> 7), j = (int)(i & 127); const int pos = p < SEQ ? p : PAST + (p - SEQ);
          const float t = (float)j / 127.0f; const float pw = (float)exp((double)t * 9.210340371976184); const float inv = 1.0f / pw;
          const float ang = (float)pos * inv; double s, c; sincos_d((double)ang, s, c); rot[i] = (f32x2){(float)c, (float)s}; } }
}

struct ThinRaw { u32x4 x[4], y[4]; };
template <bool FIRST_SRC, bool HAS_Y>
__device__ __forceinline__ void thin_load(ThinRaw& R, int r, const float* xp, const float* xs, const bf16* xb, const bf16* y, const bf16* ys, int lane) {
    if (FIRST_SRC) { const float* xr = (r < MP ? xp + (size_t)r * D : xs + (size_t)(r - MP) * D) + 8 * lane;
#pragma unroll
        for (int j = 0; j < 4; ++j) { const f32x4 a = *(const f32x4*)(xr + 512 * j), b2 = *(const f32x4*)(xr + 512 * j + 4);
            R.x[j].x = pk2(a[0], a[1]); R.x[j].y = pk2(a[2], a[3]); R.x[j].z = pk2(b2[0], b2[1]); R.x[j].w = pk2(b2[2], b2[3]); }
    } else { const bf16* xr = xb + (size_t)r * D + 8 * lane;
#pragma unroll
        for (int j = 0; j < 4; ++j) R.x[j] = *(const u32x4*)(xr + 512 * j); }
    if (HAS_Y) {
        if (ys != nullptr && r >= MP) { const bf16* yp = ys + (size_t)(r - MP) * D + 8 * lane;
#pragma unroll
            for (int j = 0; j < 4; ++j) { float a[8]; unpack8(*(const u32x4*)(yp + 512 * j), a);
#pragma unroll
                for (int s = 1; s < 8; ++s) { float t[8]; unpack8(*(const u32x4*)(yp + (size_t)s * MS * D + 512 * j), t);
#pragma unroll
                    for (int e = 0; e < 8; ++e) a[e] += t[e]; }
                R.y[j] = pack8(a); }
        } else { const bf16* yr = y + (size_t)r * D + 8 * lane;
#pragma unroll
            for (int j = 0; j < 4; ++j) R.y[j] = *(const u32x4*)(yr + 512 * j); }
    }
}
template <bool FIRST_SRC, bool HAS_Y, bool HAS_NEXT, bool LAST>
__device__ __forceinline__ void thin_phase(const float* xp, const float* xs, bf16* xb, float* out, const bf16* y, const bf16* ys, const float* mod, const float* wpost, int off_gate, float res_scale,
                                           const float* wpre, int off_shift, bf16* h, LAS unsigned char* lds, int tid, int lane, int wave) {
    asm volatile("" : "+v"(tid), "+v"(lane));
    LAS float* Wp = (LAS float*)lds;
    LAS float* Mv = Wp + 4096;
    const int gw = blockIdx.x * 8 + wave;
    const int nit = blockIdx.x < 128 ? 5 : 4;
    { const f32x4 a0 = *(const f32x4*)(wpost + 4 * tid), a1 = *(const f32x4*)(wpre + 4 * tid);
      f32x4 mm[5][3];
#pragma unroll
      for (int k = 0; k < 5; ++k) { const int mbn = (k < 4) ? k : NB + (int)blockIdx.x; const float* modr = mod + (size_t)mbn * NMOD;
          if (k < nit) { mm[k][0] = *(const f32x4*)(modr + off_gate + 4 * tid); mm[k][1] = *(const f32x4*)(modr + off_shift + 4 * tid); mm[k][2] = *(const f32x4*)(modr + off_shift + D + 4 * tid); } }
      *(LAS f32x4*)(Wp + 4 * tid) = a0; *(LAS f32x4*)(Wp + 2048 + 4 * tid) = a1;
#pragma unroll
      for (int k = 0; k < 5; ++k) if (k < nit) { LAS float* mn = Mv + k * 6144; *(LAS f32x4*)(mn + 4 * tid) = mm[k][0]; *(LAS f32x4*)(mn + 2048 + 4 * tid) = mm[k][1]; *(LAS f32x4*)(mn + 4096 + 4 * tid) = mm[k][2]; } }
    ThinRaw R[2];
    thin_load<FIRST_SRC, HAS_Y>(R[0], gw, xp, xs, xb, y, ys, lane);
    thin_load<FIRST_SRC, HAS_Y>(R[1], gw + 2048, xp, xs, xb, y, ys, lane);
    LDS_BARRIER();
#pragma unroll
    for (int k = 0; k < 5; ++k) { if (k < nit) {
        const int r = gw + 2048 * k;
        float x[32], yv[32];
#pragma unroll
        for (int j = 0; j < 4; ++j) { float t[8]; unpack8(R[k & 1].x[j], t);
#pragma unroll
            for (int e = 0; e < 8; ++e) x[8 * j + e] = t[e];
            if (HAS_Y) { unpack8(R[k & 1].y[j], t);
#pragma unroll
                for (int e = 0; e < 8; ++e) yv[8 * j + e] = t[e]; } }
#pragma unroll
        for (int j = 0; j < 32; ++j) { asm volatile("" : "+v"(x[j])); if (HAS_Y) asm volatile("" : "+v"(yv[j])); }
        if (k + 2 < nit) thin_load<FIRST_SRC, HAS_Y>(R[k & 1], r + 4096, xp, xs, xb, y, ys, lane);
        const LAS float* mv = Mv + k * 6144;
        if (HAS_Y) {
            float ss = 0.f;
#pragma unroll
            for (int j = 0; j < 32; ++j) ss += yv[j] * yv[j];
            ss = wave_sum(ss); const float rstd = 1.0f / sqrtf(ss * (1.0f / D) + EPS);
#pragma unroll
            for (int j = 0; j < 4; ++j) { const int c = 8 * lane + 512 * j;
#pragma unroll
                for (int hq = 0; hq < 2; ++hq) { const f32x4 g = *(const LAS f32x4*)(mv + c + 4 * hq), w = *(const LAS f32x4*)(Wp + c + 4 * hq);
#pragma unroll
                    for (int e = 0; e < 4; ++e) x[8 * j + 4 * hq + e] += (res_scale * g[e]) * (yv[8 * j + 4 * hq + e] * rstd * w[e]); }
                if (LAST) { *(f32x4*)(out + (size_t)r * D + c) = (f32x4){x[8 * j], x[8 * j + 1], x[8 * j + 2], x[8 * j + 3]}; *(f32x4*)(out + (size_t)r * D + c + 4) = (f32x4){x[8 * j + 4], x[8 * j + 5], x[8 * j + 6], x[8 * j + 7]}; }
                else { u32x4 o; o.x = pk2(x[8 * j], x[8 * j + 1]); o.y = pk2(x[8 * j + 2], x[8 * j + 3]); o.z = pk2(x[8 * j + 4], x[8 * j + 5]); o.w = pk2(x[8 * j + 6], x[8 * j + 7]); *(u32x4*)(xb + (size_t)r * D + c) = o; } }
        }
        if (HAS_NEXT) {
            float ss = 0.f;
#pragma unroll
            for (int j = 0; j < 32; ++j) ss += x[j] * x[j];
            ss = wave_sum(ss); const float rstd = 1.0f / sqrtf(ss * (1.0f / D) + EPS);
#pragma unroll
            for (int j = 0; j < 4; ++j) { const int c = 8 * lane + 512 * j; float hv[8];
#pragma unroll
                for (int hq = 0; hq < 2; ++hq) { const f32x4 sh = *(const LAS f32x4*)(mv + 2048 + c + 4 * hq), sc = *(const LAS f32x4*)(mv + 4096 + c + 4 * hq), w = *(const LAS f32x4*)(Wp + 2048 + c + 4 * hq);
#pragma unroll
                    for (int e = 0; e < 4; ++e) hv[4 * hq + e] = (x[8 * j + 4 * hq + e] * rstd * w[e]) * (1.0f + sc[e]) + sh[e]; }
                *(u32x4*)(h + (size_t)r * D + c) = pack8(hv); }
        }
    } }
    LDS_BARRIER();
}

struct RetRegs { u32x4 qa[2][2], ka[2][2]; f32x4 rt[2][4]; u32x4 vv; };
__device__ __forceinline__ void ret_chunk_load(RetRegs& R, const bf16* P, const f32x2* ROT, int b, int h, int vs, int n, int tid) {
    const int r0 = b * SEQ + n * 64;
#pragma unroll
    for (int i = 0; i < 2; ++i) { const int rem = tid + 512 * i, row = rem >> 4, d0 = (rem & 15) * 8;
        const bf16* src = P + (size_t)(r0 + row) * RIN + h * 256;
        R.qa[i][0] = *(const u32x4*)(src + d0); R.qa[i][1] = *(const u32x4*)(src + 128 + d0);
        R.ka[i][0] = *(const u32x4*)(src + 2048 + d0); R.ka[i][1] = *(const u32x4*)(src + 2048 + 128 + d0);
        const f32x4* rp = (const f32x4*)(ROT + (size_t)(n * 64 + row) * 128 + d0);
#pragma unroll
        for (int j = 0; j < 4; ++j) R.rt[i][j] = rp[j]; }
    { const int row = tid >> 3, g8 = (tid & 7) * 8; R.vv = *(const u32x4*)(P + (size_t)(r0 + row) * RIN + 4096 + h * 512 + vs * 64 + g8); }
}
__device__ __forceinline__ void ret_prompt_item(int it, const bf16* P, const f32x2* ROT, bf16* OB, float* retp, LAS unsigned char* lds, int tid, int lane, int wave) {
    const int b = it >> 6, h = (it >> 3) & 7, vs = it & 7;
    LAS bf16* Qs = (LAS bf16*)lds;
    LAS bf16* Ks = Qs + 64 * 264;
    LAS bf16* STs = Ks + 64 * 264;
    LAS bf16* Vs = STs + 64 * 264;
    LAS bf16* VDs = Vs + 64 * 72;
    LAS bf16* SCs = VDs + 64 * 72;
    const float lg = log1pf(-exp2f(-5.0f - (float)h));
    const float cd = __expf(lg * 64.0f);
    f32x4 accS[8];
#pragma unroll
    for (int e = 0; e < 8; ++e) accS[e] = (f32x4){0.f, 0.f, 0.f, 0.f};
    const int fr = lane & 15, fq = lane >> 4;
    RetRegs R; ret_chunk_load(R, P, ROT, b, h, vs, 0, tid);
    for (int n = 0; n < 32; ++n) {
        const int r0 = b * SEQ + n * 64;
#pragma unroll
        for (int e = 0; e < 8; ++e) { const int T = wave * 8 + e, dt = T >> 2, vt = T & 3; u32x2 w; w.x = pk2(accS[e][0], accS[e][1]); w.y = pk2(accS[e][2], accS[e][3]);
            *(LAS u32x2*)(STs + (16 * vt + fr) * 264 + 16 * dt + 4 * fq) = w; }
#pragma unroll
        for (int i = 0; i < 2; ++i) { const int rem = tid + 512 * i, row = rem >> 4, d0 = (rem & 15) * 8;
#pragma unroll
            for (int which = 0; which < 2; ++which) {
                float x1[8], x2[8], y1[8], y2[8]; unpack8(which ? R.ka[i][0] : R.qa[i][0], x1); unpack8(which ? R.ka[i][1] : R.qa[i][1], x2);
#pragma unroll
                for (int j2 = 0; j2 < 4; ++j2) { const f32x4 cs = R.rt[i][j2];
                    y1[2 * j2] = x1[2 * j2] * cs[0] - x2[2 * j2] * cs[1]; y2[2 * j2] = x1[2 * j2] * cs[1] + x2[2 * j2] * cs[0];
                    y1[2 * j2 + 1] = x1[2 * j2 + 1] * cs[2] - x2[2 * j2 + 1] * cs[3]; y2[2 * j2 + 1] = x1[2 * j2 + 1] * cs[3] + x2[2 * j2 + 1] * cs[2]; }
                if (which == 0) {
#pragma unroll
                    for (int j = 0; j < 8; ++j) { y1[j] *= 0.0625f; y2[j] *= 0.0625f; }
                    *(LAS u32x4*)(Qs + row * 264 + d0) = pack8(y1); *(LAS u32x4*)(Qs + row * 264 + 128 + d0) = pack8(y2);
                } else { *(LAS u32x4*)(Ks + row * 264 + d0) = pack8(y1); *(LAS u32x4*)(Ks + row * 264 + 128 + d0) = pack8(y2); } } }
        { const int row = tid >> 3, g8 = (tid & 7) * 8; *(LAS u32x4*)(Vs + row * 72 + g8) = R.vv;
          float v[8]; unpack8(R.vv, v); const float kd = __expf(lg * (float)(63 - row));
#pragma unroll
          for (int j = 0; j < 8; ++j) v[j] *= kd;
          *(LAS u32x4*)(VDs + row * 72 + g8) = pack8(v); }
        if (n + 1 < 32) ret_chunk_load(R, P, ROT, b, h, vs, n + 1, tid);
        LDS_BARRIER();
        { const int itile = wave >> 1, jt0 = 2 * (wave & 1); bf16x8 qf[8]; f32x4 acc[2];
#pragma unroll
          for (int ks = 0; ks < 8; ++ks) qf[ks] = frag_n(Qs + itile * 16 * 264, 264, 32 * ks, lane);
#pragma unroll
          for (int e = 0; e < 2; ++e) { acc[e] = (f32x4){0.f, 0.f, 0.f, 0.f};
#pragma unroll
              for (int ks = 0; ks < 8; ++ks) acc[e] = MFMA16(frag_n(Ks + (jt0 + e) * 16 * 264, 264, 32 * ks, lane), qf[ks], acc[e]); }
#pragma unroll
          for (int e = 0; e < 2; ++e) { const int i = 16 * itile + fr, j0 = 16 * (jt0 + e) + 4 * fq; float v[4];
#pragma unroll
              for (int ii = 0; ii < 4; ++ii) { const int j = j0 + ii; v[ii] = (i >= j) ? acc[e][ii] * __expf(lg * (float)(i - j)) : 0.f; }
              u32x2 w; w.x = pk2(v[0], v[1]); w.y = pk2(v[2], v[3]); *(LAS u32x2*)(SCs + i * 72 + j0) = w; } }
        LDS_BARRIER();
        { const int vt = wave >> 1, it0 = 2 * (wave & 1); bf16x8 vf[2], sf[8]; f32x4 intra[2], inter[2];
#pragma unroll
          for (int ks = 0; ks < 2; ++ks) vf[ks] = frag_tr(Vs + vt * 16 + 32 * ks * 72, 72, lane);
#pragma unroll
          for (int ks = 0; ks < 8; ++ks) sf[ks] = frag_n(STs + vt * 16 * 264, 264, 32 * ks, lane);
#pragma unroll
          for (int e = 0; e < 2; ++e) { intra[e] = (f32x4){0.f, 0.f, 0.f, 0.f}; inter[e] = (f32x4){0.f, 0.f, 0.f, 0.f};
#pragma unroll
              for (int ks = 0; ks < 2; ++ks) intra[e] = MFMA16(vf[ks], frag_n(SCs + (it0 + e) * 16 * 72, 72, 32 * ks, lane), intra[e]);
#pragma unroll
              for (int ks = 0; ks < 8; ++ks) inter[e] = MFMA16(sf[ks], frag_n(Qs + (it0 + e) * 16 * 264, 264, 32 * ks, lane), inter[e]); }
          bf16x8 kf[2][2], vdf[4][2];
#pragma unroll
          for (int a = 0; a < 2; ++a)
#pragma unroll
              for (int ks = 0; ks < 2; ++ks) kf[a][ks] = frag_tr(Ks + (2 * wave + a) * 16 + 32 * ks * 264, 264, lane);
#pragma unroll
          for (int v4 = 0; v4 < 4; ++v4)
#pragma unroll
              for (int ks = 0; ks < 2; ++ks) vdf[v4][ks] = frag_tr(VDs + v4 * 16 + 32 * ks * 72, 72, lane);
#pragma unroll
          for (int e = 0; e < 8; ++e) { accS[e] = accS[e] * cd;
#pragma unroll
              for (int ks = 0; ks < 2; ++ks) accS[e] = MFMA16(kf[e >> 2][ks], vdf[e & 3][ks], accS[e]); }
#pragma unroll
          for (int e = 0; e < 2; ++e) { const int i = 16 * (it0 + e) + fr, v0 = 16 * vt + 4 * fq; const float qd = __expf(lg * (float)(i + 1));
              const f32x4 ov = intra[e] + qd * inter[e]; u32x2 w; w.x = pk2(ov[0], ov[1]); w.y = pk2(ov[2], ov[3]); *(u32x2*)(OB + (size_t)(r0 + i) * RV + h * 512 + vs * 64 + v0) = w; } }
        LDS_BARRIER();
    }
#pragma unroll
    for (int e = 0; e < 8; ++e) { const int T = wave * 8 + e, dt = T >> 2, vt = T & 3;
#pragma unroll
        for (int ii = 0; ii < 4; ++ii) retp[((size_t)(b * 8 + h) * 256 + 16 * dt + 4 * fq + ii) * 512 + vs * 64 + 16 * vt + fr] = accS[e][ii]; }
}

__device__ __forceinline__ void ret_sample_item(int it, const bf16* P, const f32x2* ROT, const float* S0, bf16* OB, float* rets, LAS unsigned char* lds, int tid, int lane, int wave) {
    const int b = it >> 3, h = it & 7;
    LAS float* QsT = (LAS float*)lds;
    LAS float* KdT = QsT + 2048;
    LAS float* Qf = KdT + 2048;
    LAS float* Kf = Qf + 2048;
    LAS float* As = Kf + 2048;
    LAS float* red = As + 64;
    const float lg = log1pf(-exp2f(-5.0f - (float)h));
    const int rbase = MP + b * DSEQ;
#pragma unroll 1
    for (int i = 0; i < 4; ++i) { const int idx = tid + 512 * i, which = idx >> 10, rem = idx & 1023, n = rem >> 7, j = rem & 127;
        const bf16* src = P + (size_t)(rbase + n) * RIN + which * 2048 + h * 256;
        const float x1 = bf2f(src[j]), x2 = bf2f(src[128 + j]); const f32x2 cs = ROT[(size_t)(SEQ + n) * 128 + j];
        float y1 = x1 * cs[0] - x2 * cs[1], y2 = x1 * cs[1] + x2 * cs[0];
        if (which == 0) { y1 *= 0.0625f; y2 *= 0.0625f; QsT[j * 8 + n] = y1; QsT[(128 + j) * 8 + n] = y2; Qf[n * 256 + j] = y1; Qf[n * 256 + 128 + j] = y2; }
        else { const float kd = __expf(lg * (float)(7 - n)); KdT[j * 8 + n] = y1 * kd; KdT[(128 + j) * 8 + n] = y2 * kd; Kf[n * 256 + j] = y1; Kf[n * 256 + 128 + j] = y2; } }
    const int vq = tid & 127, dg = tid >> 7;
    f32x4 vreg[8];
#pragma unroll
    for (int n = 0; n < 8; ++n) { const u32x2 w = *(const u32x2*)(P + (size_t)(rbase + n) * RIN + 4096 + h * 512 + 4 * vq); vreg[n] = (f32x4){bflo(w.x), bfhi(w.x), bflo(w.y), bfhi(w.y)}; }
    LDS_BARRIER();
    { const int p = tid >> 3, part = tid & 7, n = p >> 3, m = p & 7; float s = 0.f;
#pragma unroll 8
      for (int d = 0; d < 32; ++d) s += Qf[n * 256 + part * 32 + d] * Kf[m * 256 + part * 32 + d];
      s += __shfl_xor(s, 1); s += __shfl_xor(s, 2); s += __shfl_xor(s, 4);
      if (part == 0) As[n * 8 + m] = (m <= n) ? s * __expf(lg * (float)(n - m)) : 0.f; }
    LDS_BARRIER();
    f32x4 oi[8];
#pragma unroll
    for (int n = 0; n < 8; ++n) oi[n] = (f32x4){0.f, 0.f, 0.f, 0.f};
    const float g8 = __expf(lg * 8.0f);
    const float* sp = S0 + ((size_t)(b * 8 + h) * 256 + dg * 64) * 512 + 4 * vq;
    float* dp = rets + ((size_t)(b * 8 + h) * 256 + dg * 64) * 512 + 4 * vq;
    f32x4 sc[8], sn[8];
#pragma unroll
    for (int u = 0; u < 8; ++u) sc[u] = *(const f32x4*)(sp + (size_t)u * 512);
#pragma unroll 1
    for (int d0 = 0; d0 < 64; d0 += 8) {
        if (d0 + 8 < 64) {
#pragma unroll
            for (int u = 0; u < 8; ++u) sn[u] = *(const f32x4*)(sp + (size_t)(d0 + 8 + u) * 512); }
#pragma unroll
        for (int u = 0; u < 8; ++u) { const int d = dg * 64 + d0 + u;
            const f32x4 s4 = sc[u];
            const f32x4 qa = *(const LAS f32x4*)(QsT + d * 8), qb = *(const LAS f32x4*)(QsT + d * 8 + 4), ka = *(const LAS f32x4*)(KdT + d * 8), kb = *(const LAS f32x4*)(KdT + d * 8 + 4);
            f32x4 snw = s4 * g8;
#pragma unroll
            for (int n = 0; n < 4; ++n) { oi[n] += qa[n] * s4; oi[n + 4] += qb[n] * s4; snw += ka[n] * vreg[n]; snw += kb[n] * vreg[n + 4]; }
            *(f32x4*)(dp + (size_t)(d0 + u) * 512) = snw; }
#pragma unroll
        for (int u = 0; u < 8; ++u) sc[u] = sn[u];
    }
#pragma unroll
    for (int n = 0; n < 8; ++n) *(LAS f32x4*)(red + (dg * 8 + n) * 512 + 4 * vq) = oi[n];
    LDS_BARRIER();
#pragma unroll
    for (int nn = 0; nn < 2; ++nn) { const int n = 2 * dg + nn;
        f32x4 o = *(const LAS f32x4*)(red + (0 * 8 + n) * 512 + 4 * vq) + *(const LAS f32x4*)(red + (1 * 8 + n) * 512 + 4 * vq) + *(const LAS f32x4*)(red + (2 * 8 + n) * 512 + 4 * vq) + *(const LAS f32x4*)(red + (3 * 8 + n) * 512 + 4 * vq);
        o = o * __expf(lg * (float)(n + 1));
#pragma unroll
        for (int m = 0; m < 8; ++m) o += As[n * 8 + m] * vreg[m];
        { u32x2 w; w.x = pk2(o[0], o[1]); w.y = pk2(o[2], o[3]); *(u32x2*)(OB + (size_t)(rbase + n) * RV + h * 512 + 4 * vq) = w; } }
    LDS_BARRIER();
}

__device__ __forceinline__ void ret_norm_phase(const bf16* OB, const bf16* P, bf16* AO, int lane, int wave) {
    const int gw = blockIdx.x * 8 + wave, NGW = gridDim.x * 8;
    for (int it0 = gw; it0 < M * 8; it0 += 4 * NGW) {
        u32x4 ov[4], gv[4];
#pragma unroll
        for (int u = 0; u < 4; ++u) { const int it = it0 + u * NGW; ov[u] = (u32x4){0u, 0u, 0u, 0u}; gv[u] = ov[u];
            if (it < M * 8) { const int r = it >> 3, h = it & 7; ov[u] = *(const u32x4*)(OB + (size_t)r * RV + h * 512 + 8 * lane); gv[u] = *(const u32x4*)(P + (size_t)r * RIN + 8192 + h * 512 + 8 * lane); } }
#pragma unroll
        for (int u = 0; u < 4; ++u) { const int it = it0 + u * NGW;
            if (it < M * 8) { const int r = it >> 3, h = it & 7; float o[8], g[8]; unpack8(ov[u], o); unpack8(gv[u], g);
                float ss = 0.f;
#pragma unroll
                for (int j = 0; j < 8; ++j) ss += o[j] * o[j];
                ss = wave_sum(ss); const float rstd = 1.0f / sqrtf(ss * (1.0f / 512.0f) + EPS);
                float r8[8];
#pragma unroll
                for (int j = 0; j < 8; ++j) r8[j] = silu_fast(g[j]) * o[j] * rstd;
                *(u32x4*)(AO + (size_t)r * RV + h * 512 + 8 * lane) = pack8(r8); } }
    }
}

__device__ __forceinline__ void mm16_f32(f32x4& acc, const LAS float* X, int ldx, const LAS float* Y, int ldy, int lane) {
    const int i = lane & 15, kq = lane >> 4;
#pragma unroll
    for (int s = 0; s < 4; ++s) { const float av = X[i * ldx + 4 * s + kq]; const float bv = Y[(4 * s + kq) * ldy + i]; acc = __builtin_amdgcn_mfma_f32_16x16x4f32(av, bv, acc, 0, 0, 0); }
}
__device__ __forceinline__ void f1_raw_load(u32x4 (&rv)[7], float& av, float& bv, const bf16* P, const float* AB, int b, int hv, int n, int tid, int lane) {
    const int hk = hv >> 1;
#pragma unroll
    for (int i = 0; i < 7; ++i) { const int idx = tid + 512 * i, row = idx / 48, ck = idx % 48, ct = ck >> 4, c8 = (ck & 15) * 8;
        const int ch0 = (ct == 0 ? hk * 128 : ct == 1 ? 2048 + hk * 128 : 4096 + hv * 128) + c8; const int tt = n * 64 + row - 3;
        rv[i] = (u32x4){0u, 0u, 0u, 0u};
        if (idx < 67 * 48 && tt >= 0) rv[i] = *(const u32x4*)(P + (size_t)(b * SEQ + tt) * GINP + ch0); }
    const int r0 = b * SEQ + n * 64; av = AB[(size_t)(r0 + lane) * 64 + hv]; bv = AB[(size_t)(r0 + lane) * 64 + 32 + hv];
}
__device__ __forceinline__ void gdn_f1_block(const bf16* P, const float* AB, const float* convw, const float* alog, const float* dtb, unsigned char* f1buf, float* GL,
                                             LAS unsigned char* lds, int tid, int lane, int wave) {
    const int it0 = (int)blockIdx.x * 16, hv = (it0 >> 5) & 31, b = it0 >> 10, hk = hv >> 1;
    LAS bf16* RAW = (LAS bf16*)lds;
    LAS float* Lf = (LAS float*)lds;
    LAS float* TF = (LAS float*)(lds + 17408);
    LAS bf16* TB = (LAS bf16*)(lds + 34816);
    LAS float* Zs = (LAS float*)(lds + 44032);
    LAS bf16* QN = (LAS bf16*)(lds + 51456);
    LAS bf16* KN = QN + 64 * 136;
    LAS bf16* VB = KN + 64 * 136;
    LAS bf16* KBG = VB + 64 * 136;
    LAS float* WT = (LAS float*)(KBG + 64 * 136);
    LAS float* gcs = WT + 4 * 384;
    LAS float* bts = gcs + 64;
    if (tid < 384) { const int ct = tid >> 7, cc = tid & 127; const int ch = (ct == 0 ? hk * 128 : ct == 1 ? 2048 + hk * 128 : 4096 + hv * 128) + cc;
#pragma unroll
        for (int tap = 0; tap < 4; ++tap) WT[tap * 384 + tid] = convw[tap * CONVCH + ch]; }
    const float nexpa = -__expf(alog[hv]), dtbv = dtb[hv];
    u32x4 rv[7]; float av, bv;
    f1_raw_load(rv, av, bv, P, AB, b, hv, it0 & 31, tid, lane);
#pragma unroll 1
    for (int kk = 0; kk < 16; ++kk) {
    const int it = it0 + kk, n = it & 31;
    unsigned char* ib = f1buf + (size_t)it * F1_ITEM;
    bf16* gQG = (bf16*)(ib + F1_QG); bf16* gW = (bf16*)(ib + F1_W); bf16* gUT = (bf16*)(ib + F1_UT); bf16* gKD = (bf16*)(ib + F1_KDT); bf16* gATT = (bf16*)(ib + F1_ATT);
    const int fr = lane & 15, fq = lane >> 4;
    { if (wave == 7) { float g = nexpa * softplus_f(av + dtbv);
#pragma unroll
          for (int o = 1; o < 64; o <<= 1) { const float t = __shfl_up(g, o); if (lane >= o) g += t; }
          gcs[lane] = g; bts[lane] = sigmoid_f(bv);
          if (lane == 63) GL[it] = __expf(g); }
#pragma unroll
      for (int i = 0; i < 7; ++i) { const int idx = tid + 512 * i; if (idx < 67 * 48) *(LAS u32x4*)(RAW + (idx / 48) * 384 + (idx % 48) * 8) = rv[i]; }
      if (kk + 1 < 16) f1_raw_load(rv, av, bv, P, AB, b, hv, n + 1, tid, lane); }
    LDS_BARRIER();
    const float gc63 = gcs[63];
    { const int g = tid & 31, isk = g >> 4, g8 = (g & 15) * 8, cb = isk * 128 + g8;
      f32x4 cw[4][2];
#pragma unroll
      for (int tap = 0; tap < 4; ++tap) { cw[tap][0] = *(const LAS f32x4*)(WT + tap * 384 + cb); cw[tap][1] = *(const LAS f32x4*)(WT + tap * 384 + cb + 4); }
#pragma unroll 1
    for (int i = 0; i < 4; ++i) { const int id = tid + 512 * i, row = id >> 5;
        float acc[8];
#pragma unroll
        for (int j = 0; j < 8; ++j) acc[j] = 0.f;
#pragma unroll
        for (int tap = 0; tap < 4; ++tap) { float xv[8]; unpack8(*(const LAS u32x4*)(RAW + (row + tap) * 384 + cb), xv);
#pragma unroll
            for (int j = 0; j < 4; ++j) { acc[j] += xv[j] * cw[tap][0][j]; acc[4 + j] += xv[4 + j] * cw[tap][1][j]; } }
        float ss = 0.f;
#pragma unroll
        for (int j = 0; j < 8; ++j) { acc[j] = silu_fast(acc[j]); ss += acc[j] * acc[j]; }
        ss += __shfl_xor(ss, 1); ss += __shfl_xor(ss, 2); ss += __shfl_xor(ss, 4); ss += __shfl_xor(ss, 8);
        const float gc = gcs[row], eg = __expf(gc);
        if (isk == 0) { const float rq = (1.0f / sqrtf(ss + EPS)) * 0.08838834764831845f; float qn[8], qg[8];
#pragma unroll
            for (int j = 0; j < 8; ++j) { qn[j] = acc[j] * rq; qg[j] = qn[j] * eg; }
            *(LAS u32x4*)(QN + row * 136 + g8) = pack8(qn); *(u32x4*)(gQG + row * 128 + g8) = pack8(qg); }
        else { const float rk = 1.0f / sqrtf(ss + EPS), bt = bts[row], egl = __expf(gc63 - gc); float kn[8], kb[8], kd[8];
#pragma unroll
            for (int j = 0; j < 8; ++j) { kn[j] = acc[j] * rk; kb[j] = kn[j] * (bt * eg); kd[j] = kn[j] * egl; }
            *(LAS u32x4*)(KN + row * 136 + g8) = pack8(kn); *(LAS u32x4*)(KBG + row * 136 + g8) = pack8(kb); *(u32x4*)(gKD + row * 128 + g8) = pack8(kd); } } }
    { const int g8 = (tid & 15) * 8, cb = 256 + g8;
      f32x4 cw[4][2];
#pragma unroll
      for (int tap = 0; tap < 4; ++tap) { cw[tap][0] = *(const LAS f32x4*)(WT + tap * 384 + cb); cw[tap][1] = *(const LAS f32x4*)(WT + tap * 384 + cb + 4); }
#pragma unroll 1
    for (int i = 0; i < 2; ++i) { const int id = tid + 512 * i, row = id >> 4;
        float acc[8];
#pragma unroll
        for (int j = 0; j < 8; ++j) acc[j] = 0.f;
#pragma unroll
        for (int tap = 0; tap < 4; ++tap) { float xv[8]; unpack8(*(const LAS u32x4*)(RAW + (row + tap) * 384 + cb), xv);
#pragma unroll
            for (int j = 0; j < 4; ++j) { acc[j] += xv[j] * cw[tap][0][j]; acc[4 + j] += xv[4 + j] * cw[tap][1][j]; } }
        const float bt = bts[row]; float vb[8];
#pragma unroll
        for (int j = 0; j < 8; ++j) vb[j] = silu_fast(acc[j]) * bt;
        *(LAS u32x4*)(VB + row * 136 + g8) = pack8(vb); } }
    LDS_BARRIER();
    { const int itile = wave >> 1, jt0 = 2 * (wave & 1); bf16x8 kif[4], qif[4]; f32x4 kk[2], qk[2];
#pragma unroll
      for (int ks = 0; ks < 4; ++ks) { kif[ks] = frag_n(KN + itile * 16 * 136, 136, 32 * ks, lane); qif[ks] = frag_n(QN + itile * 16 * 136, 136, 32 * ks, lane); }
#pragma unroll
      for (int e = 0; e < 2; ++e) { kk[e] = (f32x4){0.f, 0.f, 0.f, 0.f}; qk[e] = (f32x4){0.f, 0.f, 0.f, 0.f};
#pragma unroll
          for (int ks = 0; ks < 4; ++ks) { const bf16x8 kj = frag_n(KN + (jt0 + e) * 16 * 136, 136, 32 * ks, lane); kk[e] = MFMA16(kj, kif[ks], kk[e]); qk[e] = MFMA16(kj, qif[ks], qk[e]); } }
#pragma unroll
      for (int e = 0; e < 2; ++e) { const int i = 16 * itile + fr, j0 = 16 * (jt0 + e) + 4 * fq; const float gi = gcs[i], bi = bts[i]; float lv[4], av[4];
#pragma unroll
          for (int ii = 0; ii < 4; ++ii) { const int j = j0 + ii; const float dec = (j <= i) ? __expf(gi - gcs[j]) : 0.f; lv[ii] = (j < i) ? bi * kk[e][ii] * dec : 0.f; av[ii] = qk[e][ii] * dec; }
          *(LAS f32x4*)(Lf + i * 68 + j0) = (f32x4){lv[0], lv[1], lv[2], lv[3]};
          u32x2 w; w.x = pk2(av[0], av[1]); w.y = pk2(av[2], av[3]); *(u32x2*)(gATT + i * 64 + j0) = w; } }
    LDS_BARRIER();
    if (wave == 0) {
        const int blk = lane >> 4, c = lane & 15;
        { float t[16];
#pragma unroll
          for (int r = 0; r < 16; ++r) { float s = (r == c) ? 1.f : 0.f;
#pragma unroll
              for (int k = 0; k < r; ++k) s -= Lf[(16 * blk + r) * 68 + 16 * blk + k] * t[k];
              t[r] = s; TF[(16 * blk + r) * 68 + 16 * blk + c] = s; } }
#pragma unroll
        for (int lev = 1; lev < 4; ++lev) {
#pragma unroll
            for (int bj = 0; bj + lev < 4; ++bj) { const int bi = bj + lev; f32x4 z = (f32x4){0.f, 0.f, 0.f, 0.f};
#pragma unroll
                for (int bk = bj; bk < bi; ++bk) mm16_f32(z, Lf + (16 * bi) * 68 + 16 * bk, 68, TF + (16 * bk) * 68 + 16 * bj, 68, lane);
#pragma unroll
                for (int r = 0; r < 4; ++r) Zs[(4 * blk + r) * 17 + c] = z[r];
                f32x4 tn = (f32x4){0.f, 0.f, 0.f, 0.f};
                mm16_f32(tn, TF + (16 * bi) * 68 + 16 * bi, 68, Zs, 17, lane);
#pragma unroll
                for (int r = 0; r < 4; ++r) TF[(16 * bi + 4 * blk + r) * 68 + 16 * bj + c] = -tn[r]; } }
        { const int i = lane, ib2 = lane >> 4;
#pragma unroll
          for (int jb = 0; jb < 4; ++jb) { float v[16];
#pragma unroll
              for (int q4 = 0; q4 < 4; ++q4) { const f32x4 x = *(const LAS f32x4*)(TF + i * 68 + 16 * jb + 4 * q4); v[4 * q4] = x[0]; v[4 * q4 + 1] = x[1]; v[4 * q4 + 2] = x[2]; v[4 * q4 + 3] = x[3]; }
              const bool on = jb <= ib2;
              u32x4 w0, w1;
              w0.x = on ? pk2(v[0], v[1]) : 0u; w0.y = on ? pk2(v[2], v[3]) : 0u; w0.z = on ? pk2(v[4], v[5]) : 0u; w0.w = on ? pk2(v[6], v[7]) : 0u;
              w1.x = on ? pk2(v[8], v[9]) : 0u; w1.y = on ? pk2(v[10], v[11]) : 0u; w1.z = on ? pk2(v[12], v[13]) : 0u; w1.w = on ? pk2(v[14], v[15]) : 0u;
              *(LAS u32x4*)(TB + i * 72 + 16 * jb) = w0; *(LAS u32x4*)(TB + i * 72 + 16 * jb + 8) = w1; } }
    }
    LDS_BARRIER();
    { bf16x8 vbf[2], kbf[2]; f32x4 au[4], aw[4];
#pragma unroll
      for (int ks = 0; ks < 2; ++ks) { vbf[ks] = frag_tr(VB + wave * 16 + 32 * ks * 136, 136, lane); kbf[ks] = frag_tr(KBG + wave * 16 + 32 * ks * 136, 136, lane); }
#pragma unroll
      for (int e = 0; e < 4; ++e) { au[e] = (f32x4){0.f, 0.f, 0.f, 0.f}; aw[e] = (f32x4){0.f, 0.f, 0.f, 0.f};
#pragma unroll
          for (int ks = 0; ks < 2; ++ks) { const bf16x8 tf = frag_n(TB + e * 16 * 72, 72, 32 * ks, lane);
              au[e] = MFMA16(tf, vbf[ks], au[e]);
              aw[e] = MFMA16(kbf[ks], tf, aw[e]); } }
#pragma unroll
      for (int e = 0; e < 4; ++e) { u32x2 w; w.x = pk2(au[e][0], au[e][1]); w.y = pk2(au[e][2], au[e][3]); *(u32x2*)(gUT + (16 * wave + fr) * 64 + 16 * e + 4 * fq) = w;
          w.x = pk2(aw[e][0], aw[e][1]); w.y = pk2(aw[e][2], aw[e][3]); *(u32x2*)(gW + (16 * e + fr) * 128 + 16 * wave + 4 * fq) = w; } }
    LDS_BARRIER();
    }
}

struct F2Regs { u32x4 w[2], qg[2], kd[2], att, z[2]; u32x2 ut[4]; float gl; };
__device__ __forceinline__ void f2_load(F2Regs& R, const unsigned char* f1buf, const float* GL, const bf16* P, int it, int n, int tid, int lane, int wave) {
    const int item = it * 32 + n; const unsigned char* ib = f1buf + (size_t)item * F1_ITEM; const int b = it >> 5, hv = it & 31;
    const u32x4* s = (const u32x4*)(ib + F1_W); R.w[0] = s[tid]; R.w[1] = s[tid + 512];
    s = (const u32x4*)(ib + F1_QG); R.qg[0] = s[tid]; R.qg[1] = s[tid + 512];
    s = (const u32x4*)(ib + F1_KDT); R.kd[0] = s[tid]; R.kd[1] = s[tid + 512];
    s = (const u32x4*)(ib + F1_ATT); R.att = s[tid];
    const bf16* gUT = (const bf16*)(ib + F1_UT); const int fr = lane & 15, fq = lane >> 4;
#pragma unroll
    for (int e = 0; e < 4; ++e) { const int t = wave * 4 + e, ctile = t & 3, vt = t >> 2; R.ut[e] = *(const u32x2*)(gUT + (16 * vt + fr) * 64 + 16 * ctile + 4 * fq); }
    { const int c = tid >> 3, part = tid & 7; const bf16* zp = P + (size_t)(b * SEQ + n * 64 + c) * GINP + 8192 + hv * 128 + part * 16; R.z[0] = *(const u32x4*)zp; R.z[1] = *(const u32x4*)(zp + 8); }
    R.gl = GL[item];
}
__device__ __forceinline__ void gdn_f2_item(int it, const unsigned char* f1buf, const float* GL, const bf16* P, const float* normw, bf16* AO, float* gdnp,
                                            LAS unsigned char* lds, int tid, int lane, int wave) {
    const int b = it >> 5, hv = it & 31;
    LAS bf16* STs = (LAS bf16*)lds;
    LAS bf16* Ws = STs + 128 * 136;
    LAS bf16* QGs = Ws + 64 * 136;
    LAS bf16* KDs = QGs + 64 * 136;
    LAS bf16* ATs = KDs + 64 * 136;
    LAS bf16* VNTs = ATs + 64 * 72;
    LAS float* Os = (LAS float*)(VNTs + 128 * 72);
    const int fr = lane & 15, fq = lane >> 4;
    f32x4 accS[8];
#pragma unroll
    for (int e = 0; e < 8; ++e) accS[e] = (f32x4){0.f, 0.f, 0.f, 0.f};
    F2Regs R; f2_load(R, f1buf, GL, P, it, 0, tid, lane, wave);
    float nw[16];
    { const int part = tid & 7;
#pragma unroll
      for (int j = 0; j < 16; ++j) nw[j] = normw[part * 16 + j]; }
    for (int n = 0; n < 32; ++n) {
        const int r0 = b * SEQ + n * 64;
#pragma unroll
        for (int i = 0; i < 2; ++i) { const int idx = tid + 512 * i, row = idx >> 4, c8 = (idx & 15) * 8;
            *(LAS u32x4*)(Ws + row * 136 + c8) = R.w[i]; *(LAS u32x4*)(QGs + row * 136 + c8) = R.qg[i]; *(LAS u32x4*)(KDs + row * 136 + c8) = R.kd[i]; }
        { const int row = tid >> 3, c8 = (tid & 7) * 8; *(LAS u32x4*)(ATs + row * 72 + c8) = R.att; }
#pragma unroll
        for (int e = 0; e < 8; ++e) { const int T = wave * 8 + e, dt = T >> 3, vt = T & 7; u32x2 w; w.x = pk2(accS[e][0], accS[e][1]); w.y = pk2(accS[e][2], accS[e][3]);
            *(LAS u32x2*)(STs + (16 * vt + fr) * 136 + 16 * dt + 4 * fq) = w; }
        u32x2 utc[4]; u32x4 zc[2]; float gl = R.gl;
#pragma unroll
        for (int e = 0; e < 4; ++e) utc[e] = R.ut[e];
        zc[0] = R.z[0]; zc[1] = R.z[1];
        asm volatile("" : "+v"(utc[0]), "+v"(utc[1]), "+v"(utc[2]), "+v"(utc[3]), "+v"(zc[0]), "+v"(zc[1]), "+v"(gl));
        if (n + 1 < 32) f2_load(R, f1buf, GL, P, it, n + 1, tid, lane, wave);
        LDS_BARRIER();
        bf16x8 sf[4];
#pragma unroll
        for (int ks = 0; ks < 4; ++ks) sf[ks] = frag_n(STs + wave * 16 * 136, 136, 32 * ks, lane);
        { f32x4 acc[4];
#pragma unroll
          for (int e = 0; e < 4; ++e) { acc[e] = (f32x4){0.f, 0.f, 0.f, 0.f};
#pragma unroll
              for (int ks = 0; ks < 4; ++ks) acc[e] = MFMA16(frag_n(Ws + e * 16 * 136, 136, 32 * ks, lane), sf[ks], acc[e]); }
#pragma unroll
          for (int e = 0; e < 4; ++e) { const u32x2 uw = utc[e];
              u32x2 w; w.x = pk2(bflo(uw.x) - acc[e][0], bfhi(uw.x) - acc[e][1]); w.y = pk2(bflo(uw.y) - acc[e][2], bfhi(uw.y) - acc[e][3]);
              *(LAS u32x2*)(VNTs + (16 * wave + fr) * 72 + 16 * e + 4 * fq) = w; } }
        LDS_BARRIER();
        { f32x4 acc[4]; bf16x8 vf[2];
#pragma unroll
          for (int ks = 0; ks < 2; ++ks) vf[ks] = frag_n(VNTs + wave * 16 * 72, 72, 32 * ks, lane);
#pragma unroll
          for (int e = 0; e < 4; ++e) { acc[e] = (f32x4){0.f, 0.f, 0.f, 0.f};
#pragma unroll
              for (int ks = 0; ks < 4; ++ks) acc[e] = MFMA16(sf[ks], frag_n(QGs + e * 16 * 136, 136, 32 * ks, lane), acc[e]);
#pragma unroll
              for (int ks = 0; ks < 2; ++ks) acc[e] = MFMA16(vf[ks], frag_n(ATs + e * 16 * 72, 72, 32 * ks, lane), acc[e]); }
          bf16x8 kf[2];
#pragma unroll
          for (int ks = 0; ks < 2; ++ks) kf[ks] = frag_tr(KDs + wave * 16 + 32 * ks * 136, 136, lane);
#pragma unroll
          for (int e = 0; e < 8; ++e) { accS[e] = accS[e] * gl;
#pragma unroll
              for (int ks = 0; ks < 2; ++ks) accS[e] = MFMA16(kf[ks], frag_n(VNTs + e * 16 * 72, 72, 32 * ks, lane), accS[e]); }
#pragma unroll
          for (int e = 0; e < 4; ++e) *(LAS f32x4*)(Os + (16 * e + fr) * 132 + 16 * wave + 4 * fq) = acc[e]; }
        LDS_BARRIER();
        { const int c = tid >> 3, part = tid & 7; float o[16]; float ss = 0.f;
#pragma unroll
          for (int j = 0; j < 4; ++j) { const f32x4 v = *(const LAS f32x4*)(Os + c * 132 + part * 16 + 4 * j); o[4 * j] = v[0]; o[4 * j + 1] = v[1]; o[4 * j + 2] = v[2]; o[4 * j + 3] = v[3];
              ss += (v[0] * v[0] + v[1] * v[1]) + (v[2] * v[2] + v[3] * v[3]); }
          ss += __shfl_xor(ss, 1); ss += __shfl_xor(ss, 2); ss += __shfl_xor(ss, 4);
          const float rstd = 1.0f / sqrtf(ss * (1.0f / 128.0f) + EPS);
          float z[16]; { float t8[8]; unpack8(zc[0], t8);
#pragma unroll
              for (int j = 0; j < 8; ++j) z[j] = t8[j];
              unpack8(zc[1], t8);
#pragma unroll
              for (int j = 0; j < 8; ++j) z[8 + j] = t8[j]; }
          float r[16];
#pragma unroll
          for (int j = 0; j < 16; ++j) r[j] = o[j] * rstd * nw[j] * silu_fast(z[j]);
          bf16* ap = AO + (size_t)(r0 + c) * RV + hv * 128 + part * 16; u32x4 w;
          w.x = pk2(r[0], r[1]); w.y = pk2(r[2], r[3]); w.z = pk2(r[4], r[5]); w.w = pk2(r[6], r[7]); *(u32x4*)ap = w;
          w.x = pk2(r[8], r[9]); w.y = pk2(r[10], r[11]); w.z = pk2(r[12], r[13]); w.w = pk2(r[14], r[15]); *(u32x4*)(ap + 8) = w; }
    }
#pragma unroll
    for (int e = 0; e < 8; ++e) { const int T = wave * 8 + e, dt = T >> 3, vt = T & 7;
#pragma unroll
        for (int ii = 0; ii < 4; ++ii) gdnp[((size_t)it * 128 + 16 * dt + 4 * fq + ii) * 128 + 16 * vt + fr] = accS[e][ii]; }
    LDS_BARRIER();
}

__device__ __forceinline__ void gdn_sample_wave(int item, const bf16* P, const float* AB, const float* convw, const float* alog, const float* dtb, const float* normw,
                                                const float* S0, const float* cst, bf16* AO, float* gdns, LAS float* wl, int lane) {
    const int b = item >> 5, hv = item & 31, hk = hv >> 1;
    const int rbase = MP + b * DSEQ;
    const int cp = lane & 31, hh = lane >> 5;
    float a_l, b_l;
    { const int tk = lane & 7; const float av = AB[(size_t)(rbase + tk) * 64 + hv], bv = AB[(size_t)(rbase + tk) * 64 + 32 + hv];
      a_l = __expf(-__expf(alog[hv]) * softplus_f(av + dtb[hv])); b_l = sigmoid_f(bv); }
    float kq[8];
    {
      float qk[4][8];
#pragma unroll
      for (int j = 0; j < 4; ++j) { const int ch = (j < 2 ? hk * 128 : 2048 + hk * 128) + lane + 64 * (j & 1); float f[11], w[4];
#pragma unroll
          for (int i = 0; i < 3; ++i) f[i] = cst[((size_t)b * 3 + i) * CONVCH + ch];
#pragma unroll
          for (int i = 0; i < 8; ++i) f[3 + i] = bf2f(P[(size_t)(rbase + i) * GINP + ch]);
#pragma unroll
          for (int tap = 0; tap < 4; ++tap) w[tap] = convw[tap * CONVCH + ch];
#pragma unroll
          for (int tok = 0; tok < 8; ++tok) qk[j][tok] = silu_fast(f[tok] * w[0] + f[tok + 1] * w[1] + f[tok + 2] * w[2] + f[tok + 3] * w[3]); }
#pragma unroll
      for (int tok = 0; tok < 8; ++tok) {
          const float sq = wave_sum(qk[0][tok] * qk[0][tok] + qk[1][tok] * qk[1][tok]), sk = wave_sum(qk[2][tok] * qk[2][tok] + qk[3][tok] * qk[3][tok]);
          const float rq = (1.0f / sqrtf(sq + EPS)) * 0.08838834764831845f, rk = 1.0f / sqrtf(sk + EPS);
          const float q0 = qk[0][tok] * rq, q1 = qk[1][tok] * rq, k0 = qk[2][tok] * rk, k1 = qk[3][tok] * rk;
          kq[tok] = wave_sum(q0 * k0 + q1 * k1);
          wl[tok * 256 + lane] = q0; wl[tok * 256 + 64 + lane] = q1; wl[tok * 256 + 128 + lane] = k0; wl[tok * 256 + 192 + lane] = k1; } }
    const unsigned loff = (unsigned)((64 * hh) * 128 + 2 * cp);
#pragma unroll 1
    for (int half = 0; half < 2; ++half) {
#pragma unroll
        for (int c = 0; c < 2; ++c) { const int ch = 4096 + hv * 128 + half * 64 + 2 * cp + c; float f[11], w[4];
#pragma unroll
            for (int i = 0; i < 3; ++i) f[i] = cst[((size_t)b * 3 + i) * CONVCH + ch];
#pragma unroll
            for (int i = 0; i < 8; ++i) f[3 + i] = bf2f(P[(size_t)(rbase + i) * GINP + ch]);
#pragma unroll
            for (int tap = 0; tap < 4; ++tap) w[tap] = convw[tap * CONVCH + ch];
#pragma unroll
            for (int tok = 0; tok < 8; ++tok) wl[2048 + tok * 128 + 2 * lane + c] = silu_fast(f[tok] * w[0] + f[tok + 1] * w[1] + f[tok + 2] * w[2] + f[tok + 3] * w[3]); }
        asm volatile("" ::: "memory");
        f32x2 S[64];
        { const float* sp = S0 + (size_t)item * 16384 + half * 64;
#pragma unroll
          for (int d = 0; d < 64; ++d) S[d] = *(const f32x2*)(sp + d * 128 + loff); }
#pragma unroll
        for (int tok = 0; tok < 8; ++tok) {
            const LAS f32x4* qp = (const LAS f32x4*)(wl + tok * 256 + 64 * hh); const LAS f32x4* kp = (const LAS f32x4*)(wl + tok * 256 + 128 + 64 * hh);
            f32x2 kS = (f32x2){0.f, 0.f}, qS = (f32x2){0.f, 0.f}, kS1 = (f32x2){0.f, 0.f}, qS1 = (f32x2){0.f, 0.f};
#pragma unroll
            for (int j = 0; j < 16; ++j) { const f32x4 k4 = kp[j], q4 = qp[j];
                kS += k4[0] * S[4 * j] + k4[2] * S[4 * j + 2]; kS1 += k4[1] * S[4 * j + 1] + k4[3] * S[4 * j + 3];
                qS += q4[0] * S[4 * j] + q4[2] * S[4 * j + 2]; qS1 += q4[1] * S[4 * j + 1] + q4[3] * S[4 * j + 3];
                if ((j & 3) == 3) asm volatile("" ::: "memory"); }
            kS += kS1; qS += qS1;
            kS[0] += __shfl_xor(kS[0], 32); kS[1] += __shfl_xor(kS[1], 32); qS[0] += __shfl_xor(qS[0], 32); qS[1] += __shfl_xor(qS[1], 32);
            asm volatile("" ::: "memory");
            const float a = __shfl(a_l, tok), bt = __shfl(b_l, tok);
            const f32x2 vtk = *(const LAS f32x2*)(wl + 2048 + tok * 128 + 2 * lane);
            const f32x2 dv = bt * (vtk - a * kS);
            if (hh == 0) *(LAS f32x2*)(wl + 3072 + tok * 128 + half * 64 + 2 * cp) = a * qS + kq[tok] * dv;
#pragma unroll
            for (int j = 0; j < 16; ++j) { const f32x4 k4 = kp[j];
                S[4 * j] = a * S[4 * j] + k4[0] * dv; S[4 * j + 1] = a * S[4 * j + 1] + k4[1] * dv; S[4 * j + 2] = a * S[4 * j + 2] + k4[2] * dv; S[4 * j + 3] = a * S[4 * j + 3] + k4[3] * dv;
                if ((j & 7) == 7) asm volatile("" ::: "memory"); }
        }
        { float* dp = gdns + (size_t)item * 16384 + half * 64;
#pragma unroll
          for (int d = 0; d < 64; ++d) *(f32x2*)(dp + d * 128 + loff) = S[d]; }
    }
    { const f32x2 nw = *(const f32x2*)(normw + 2 * lane);
#pragma unroll
      for (int tok = 0; tok < 8; ++tok) { const f32x2 ov = *(const LAS f32x2*)(wl + 3072 + tok * 128 + 2 * lane);
          const float ss = wave_sum(ov[0] * ov[0] + ov[1] * ov[1]); const float rstd = 1.0f / sqrtf(ss * (1.0f / 128.0f) + EPS);
          const unsigned zw = *(const unsigned*)(P + (size_t)(rbase + tok) * GINP + 8192 + hv * 128 + 2 * lane);
          *(unsigned*)(AO + (size_t)(rbase + tok) * RV + hv * 128 + 2 * lane) = pk2(ov[0] * rstd * nw[0] * silu_fast(bflo(zw)), ov[1] * rstd * nw[1] * silu_fast(bfhi(zw))); } }
}

#ifndef ONE_LAUNCH
#define ONE_LAUNCH 1
#endif

template <class Epi>
__device__ __forceinline__ void run_gemm(LAS unsigned char* lds, const bf16* A, const bf16* Bt, int m, int n, int k, const Epi& E) {
    pg8::Gemm g{A, Bt, m, n, k}; pg8::StaticOrder S; S.init(m, n, k, (int)gridDim.x, (int)blockIdx.x);
    pg8::gemm_phase<Epi, pg8::StaticOrder, true, true>(lds, g, S, E);
}

__device__ __forceinline__ void run_gemm_gu(LAS unsigned char* lds, const bf16* A, const bf16* Bt, bf16* ACT, bf16* SL) {
    pg8::Gemm g{A, Bt, M, NGU, D}; pg8::GuSplitOrder S; S.init(M, NGU, D, 256, (int)blockIdx.x);
    pg8::gemm_phase<pg8::EpiSwiGLUSplit, pg8::GuSplitOrder, true, true>(lds, g, S, pg8::EpiSwiGLUSplit{ACT, DFF, SL});
}
__device__ __forceinline__ void gu_fixup(bf16* ACT, const bf16* SL, int tid) {
    for (int task = (int)blockIdx.x * 512 + tid; task < 48 * 256 * 16; task += 256 * 512) { const int t = task >> 12, row = (task >> 4) & 255, g8 = (task & 15) * 8;
        pg8::StaticOrder S; S.init(M, NGU, D, 256, t); pg8::Unit u; S.next(6, u);
        const bf16* gp = SL + (size_t)t * 5 * (2 * 256 * 128) + row * 128 + g8;
        float gs[8], us[8];
#pragma unroll
        for (int e = 0; e < 8; ++e) { gs[e] = 0.f; us[e] = 0.f; }
#pragma unroll
        for (int j = 0; j < 5; ++j) { float a[8], b2[8]; unpack8(*(const u32x4*)(gp + (size_t)j * (2 * 256 * 128)), a); unpack8(*(const u32x4*)(gp + (size_t)j * (2 * 256 * 128) + 256 * 128), b2);
#pragma unroll
            for (int e = 0; e < 8; ++e) { gs[e] += a[e]; us[e] += b2[e]; } }
        float r[8];
#pragma unroll
        for (int e = 0; e < 8; ++e) r[e] = silu_fast(gs[e]) * us[e];
        *(u32x4*)(ACT + (size_t)(u.pm * 256 + row) * DFF + u.pn * 128 + g8) = pack8(r); }
}
__device__ __forceinline__ void run_gemm_n2048(LAS unsigned char* lds, const bf16* A, const bf16* Bt, int k, bf16* Y, bf16* YS) {
    pg8::Gemm g{A, Bt, M, D, k};
    if (gridDim.x == 256) { pg8::TailSplitOrder S; S.init(D, k, 256, (int)blockIdx.x); pg8::gemm_phase<pg8::EpiY, pg8::TailSplitOrder, true, true>(lds, g, S, pg8::EpiY{Y, D, YS, (size_t)MS * D}); }
    else { pg8::StaticOrder S; S.init(M, D, k, (int)gridDim.x, (int)blockIdx.x); pg8::gemm_phase<pg8::EpiY, pg8::StaticOrder, true, true>(lds, g, S, pg8::EpiY{Y, D, YS, (size_t)MS * D}); }
}

__global__ void __launch_bounds__(512, 2) fwd_kernel(Args a) {
    extern __shared__ __attribute__((aligned(16))) unsigned char lds_raw[];
    LAS unsigned char* lds = (LAS unsigned char*)lds_raw;
    const int tid = threadIdx.x, lane = tid & 63, wave = __builtin_amdgcn_readfirstlane(tid >> 6);
    const int lo = a.ph_lo, hi = a.ph_hi;
#if ONE_LAUNCH
    volatile LAS unsigned* MISC = (volatile LAS unsigned*)(lds + MISC_OFF);
    if (tid < 4) MISC[tid] = 0u;
    __syncthreads();
    XcdBarrier bar = xcd_barrier_post((unsigned*)(a.ws + WS_CTL) + (size_t)a.li * 4096, MISC);
#define SEAMB() xcd_barrier(bar)
#else
#define SEAMB() do { } while (0)
#endif
#define IN(k) (lo <= (k) && (k) < hi)
#ifndef PROBE_F1
#define PROBE_F1 1
#endif
#ifndef PROBE_GS
#define PROBE_GS 1
#endif
#ifndef PROBE_MASK
#define PROBE_MASK 0u
#endif
#ifndef PROBE_XBAR
#define PROBE_XBAR 0
#endif
#define PH(k, ...) if (IN(k)) { __VA_ARGS__ if ((k) + 1 < hi) SEAMB(); if ((k) == 2) for (int xb_ = 0; xb_ < PROBE_XBAR; ++xb_) SEAMB(); }

#define xp (a.in[0])
#define xs (a.in[1])
#define npre (a.in[9])
#define npost (a.in[10])
#define Hb ((bf16*)(a.ws + WS_H))
#define Pb ((bf16*)(a.ws + WS_P))
#define AOb ((bf16*)(a.ws + WS_AO))
#define Yb ((bf16*)(a.ws + WS_Y))
#define XBb ((bf16*)(a.ws + WS_XB))
#define YSb ((bf16*)(a.ws + WS_YS))
#define YSsel (gridDim.x == 256 ? YSb : (bf16*)nullptr)
#define OBb ((bf16*)(a.ws + WS_OB))
#define MODb ((float*)(a.ws + WS_MOD))
#define ABb ((float*)(a.ws + WS_AB))
#define GLb ((float*)(a.ws + WS_GL))
#define ROTb ((const f32x2*)(a.ws + WS_ROT))

    PH(0,  prep_phase(a, lds, tid, lane, wave);)

    PH(2,  thin_phase<true, false, true, false>(xp, xs, XBb, a.out, Yb, YSsel, MODb, npost, 0, 0.f, npre + 0 * D, 0 * LMOD + 0 * 6144, Hb, lds, tid, lane, wave);)
    PH(3,  run_gemm_gu(lds, Hb, (const bf16*)(a.ws + WS_WGU + 0 * SZ_WGU), Pb, (bf16*)(a.ws + WS_GS));)
    PH(4,  gu_fixup(Pb, (const bf16*)(a.ws + WS_GS), tid); SEAMB(); run_gemm_n2048(lds, Pb, (const bf16*)(a.ws + WS_WDN + 0 * SZ_WDN), DFF, Yb, YSb);)
    PH(5,  thin_phase<true, true, true, false>(xp, xs, XBb, a.out, Yb, YSsel, MODb, npost + 0 * D, 0 * LMOD + 0 * 6144 + 4096, 0.5f, npre + 1 * D, 0 * LMOD + 1 * 6144, Hb, lds, tid, lane, wave);)
    PH(6,  run_gemm(lds, Hb, (const bf16*)(a.ws + WS_WRI), M, RIN, D, pg8::EpiBf16G{Pb, RIN, nullptr, -1});)
    PH(7,
        for (int it = blockIdx.x; it < 256; it += gridDim.x) ret_prompt_item(it, Pb, ROTb, OBb, a.out + O_RETP, lds, tid, lane, wave);
        for (int it = blockIdx.x; it < DB * 8; it += gridDim.x) ret_sample_item(it, Pb, ROTb, a.in[4], OBb, a.out + O_RETS, lds, tid, lane, wave);)
    PH(8,  ret_norm_phase(OBb, Pb, AOb, lane, wave);)
    PH(9,  run_gemm_n2048(lds, AOb, (const bf16*)(a.ws + WS_WRO), RV, Yb, YSb);)
    PH(10,  thin_phase<false, true, true, false>(xp, xs, XBb, a.out, Yb, YSsel, MODb, npost + 1 * D, 0 * LMOD + 1 * 6144 + 4096, 1.0f, npre + 2 * D, 0 * LMOD + 2 * 6144, Hb, lds, tid, lane, wave);)
    PH(11,  run_gemm_gu(lds, Hb, (const bf16*)(a.ws + WS_WGU + 1 * SZ_WGU), Pb, (bf16*)(a.ws + WS_GS));)
    PH(12,  gu_fixup(Pb, (const bf16*)(a.ws + WS_GS), tid); SEAMB(); run_gemm_n2048(lds, Pb, (const bf16*)(a.ws + WS_WDN + 1 * SZ_WDN), DFF, Yb, YSb);)
    PH(13,  thin_phase<false, true, true, false>(xp, xs, XBb, a.out, Yb, YSsel, MODb, npost + 2 * D, 0 * LMOD + 2 * 6144 + 4096, 0.5f, npre + 3 * D, 1 * LMOD + 0 * 6144, Hb, lds, tid, lane, wave);)

    PH(14,  run_gemm_gu(lds, Hb, (const bf16*)(a.ws + WS_WGU + 2 * SZ_WGU), Pb, (bf16*)(a.ws + WS_GS));)
    PH(15,  gu_fixup(Pb, (const bf16*)(a.ws + WS_GS), tid); SEAMB(); run_gemm_n2048(lds, Pb, (const bf16*)(a.ws + WS_WDN + 2 * SZ_WDN), DFF, Yb, YSb);)
    PH(16,  thin_phase<false, true, true, false>(xp, xs, XBb, a.out, Yb, YSsel, MODb, npost + 3 * D, 1 * LMOD + 0 * 6144 + 4096, 0.5f, npre + 4 * D, 1 * LMOD + 1 * 6144, Hb, lds, tid, lane, wave);)
    PH(17,  run_gemm(lds, Hb, (const bf16*)(a.ws + WS_WGI), M, GINP, D, pg8::EpiBf16G{Pb, GINP, ABb, 48});)
    PH(18,
        gdn_f1_block(Pb, ABb, a.in[16], a.in[17], a.in[18], a.ws + WS_F1, GLb, lds, tid, lane, wave);
        { const int gt = (int)blockIdx.x * 512 + tid, GT = (int)gridDim.x * 512;
          for (int i = gt; i < (NB + DB) * 3 * (CONVCH / 8); i += GT) { const int c8 = (i % (CONVCH / 8)) * 8, j = (i / (CONVCH / 8)) % 3, bb = i / (3 * (CONVCH / 8));
              const int row = bb < NB ? bb * SEQ + SEQ - 3 + j : MP + (bb - NB) * DSEQ + DSEQ - 3 + j;
              float v[8]; unpack8(*(const u32x4*)(Pb + (size_t)row * GINP + c8), v);
              float* op = a.out + O_CONVP + (size_t)(bb * 3 + j) * CONVCH + c8; *(f32x4*)op = (f32x4){v[0], v[1], v[2], v[3]}; *(f32x4*)(op + 4) = (f32x4){v[4], v[5], v[6], v[7]}; } })
    PH(19,  if (blockIdx.x < 128) gdn_f2_item((int)blockIdx.x, a.ws + WS_F1, GLb, Pb, a.in[19], AOb, a.out + O_GDNP, lds, tid, lane, wave);
            else { LAS float* wl = (LAS float*)(lds + wave * 16384);
                   for (int item = ((int)blockIdx.x - 128) * 8 + wave; item < 4096; item += 1024)
                       gdn_sample_wave(item, Pb, ABb, a.in[16], a.in[17], a.in[18], a.in[19], a.in[5], a.in[6], AOb, a.out + O_GDNS, wl, lane); })
    PH(20,  run_gemm_n2048(lds, AOb, (const bf16*)(a.ws + WS_WGO), RV, Yb, YSb);)
    PH(21,  thin_phase<false, true, true, false>(xp, xs, XBb, a.out, Yb, YSsel, MODb, npost + 4 * D, 1 * LMOD + 1 * 6144 + 4096, 1.0f, npre + 5 * D, 1 * LMOD + 2 * 6144, Hb, lds, tid, lane, wave);)
    PH(22,  run_gemm_gu(lds, Hb, (const bf16*)(a.ws + WS_WGU + 3 * SZ_WGU), Pb, (bf16*)(a.ws + WS_GS));)
    PH(23,  gu_fixup(Pb, (const bf16*)(a.ws + WS_GS), tid); SEAMB(); run_gemm_n2048(lds, Pb, (const bf16*)(a.ws + WS_WDN + 3 * SZ_WDN), DFF, Yb, YSb);)
    PH(24, thin_phase<false, true, false, true>(xp, xs, XBb, a.out, Yb, YSsel, MODb, npost + 5 * D, 1 * LMOD + 2 * 6144 + 4096, 0.5f, npre, 0, Hb, lds, tid, lane, wave);)
#undef IN
#undef SEAMB
#undef PH
#undef xp
#undef xs
#undef npre
#undef npost
#undef Hb
#undef Pb
#undef AOb
#undef Yb
#undef XBb
#undef YSb
#undef YSsel
#undef OBb
#undef MODb
#undef ABb
#undef GLb
#undef ROTb
}

extern "C" void kernel_launch(void* const* d_in, const int* in_sizes, int n_in, void* d_out, int out_size, void* d_ws, size_t ws_size, hipStream_t stream) {
    static int grid = 0;
    if (grid == 0) {
        if (n_in != 21 || (size_t)out_size != O_END || ws_size < WS_END) { fprintf(stderr, "kernel_launch: unexpected problem: n_in %d out %d ws %zu (need %zu)\n", n_in, out_size, ws_size, (size_t)WS_END); grid = -1; return; }
        int dev = 0, cus = 0, per_cu = 0;
        if (hipGetDevice(&dev) != hipSuccess || hipDeviceGetAttribute(&cus, hipDeviceAttributeMultiprocessorCount, dev) != hipSuccess) { grid = -1; return; }
        if (hipFuncSetAttribute((const void*)fwd_kernel, hipFuncAttributeMaxDynamicSharedMemorySize, LDS_BYTES) != hipSuccess) { fprintf(stderr, "kernel_launch: hipFuncSetAttribute failed\n"); grid = -1; return; }
        if (hipOccupancyMaxActiveBlocksPerMultiprocessor(&per_cu, (const void*)fwd_kernel, 512, LDS_BYTES) != hipSuccess || per_cu < 1) { fprintf(stderr, "kernel_launch: occupancy query says %d blocks per CU\n", per_cu); }
        (void)hipGetLastError();
        if (cus < 256) { fprintf(stderr, "kernel_launch: built for a 256-CU device, found %d\n", cus); grid = -1; return; }
        grid = 256;
    }
    if (grid < 0) return;
    (void)hipMemsetAsync((char*)d_ws + WS_CTL, 0, CTL_BYTES, stream);
    Args a{};
    for (int i = 0; i < 21; ++i) a.in[i] = (const float*)d_in[i];
    a.out = (float*)d_out; a.ws = (unsigned char*)d_ws;
#if ONE_LAUNCH
    int lo = 0;
    for (int k = 0; k < NPH; ++k) if ((PROBE_MASK >> k) & 1u) { a.ph_lo = lo; a.ph_hi = k + 1; hipLaunchKernelGGL(fwd_kernel, dim3(grid), dim3(512), LDS_BYTES, stream, a); lo = k; ++a.li; }
    a.ph_lo = lo; a.ph_hi = NPH;
    hipLaunchKernelGGL(fwd_kernel, dim3(grid), dim3(512), LDS_BYTES, stream, a);
#else
    for (int k = 0; k < NPH; ++k) { a.ph_lo = k; a.ph_hi = k + 1; hipLaunchKernelGGL(fwd_kernel, dim3(grid), dim3(512), LDS_BYTES, stream, a); }
#endif
    const hipError_t le = hipPeekAtLastError();
    if (le != hipSuccess) fprintf(stderr, "kernel_launch: launch failed: %s\n", hipGetErrorName(le));
}
```
